# Optimizing an MI355X kernel written in HIP

```python
import math
import jax, jax.numpy as jnp
from jax import lax
import numpy as np

D_MODEL = 1024
BATCH = 16
SEQ = 2048
DEPTH = 1

RNN_WIDTH = 1024
RNN_BLOCKS = 16
RNN_BLOCK_DIM = RNN_WIDTH // RNN_BLOCKS
CONV_WIDTH = 4
LRU_C = 8.0
N_HEADS = 8
HEAD_DIM = 128
ATTN_WIDTH = N_HEADS * HEAD_DIM
ROPE_DIM = HEAD_DIM // 4
ROPE_THETA = 500000.0
MOBA_BLOCK = 256
MOBA_TOPK = 3
Q_CHUNK = 256
N_EXPERTS = 32
TOP_K = 4
D_EXPERT = 1024
SWIGLU_LIMIT = 7.0
SWIGLU_ALPHA = 1.702
EXPERT_ROWS = 256
EPS = 1e-6
NEG = -1e30

kernel_name = 'hybrid_rglru_moba_moe'


def rms_norm(x, g):
    xf = x.astype(jnp.float32)
    y = xf * lax.rsqrt(jnp.mean(xf * xf, axis=-1, keepdims=True) + EPS)
    return (y * g.astype(jnp.float32)).astype(x.dtype)


def causal_depthwise_conv(x, w, b):
    s = x.shape[1]
    xp = jnp.pad(x, ((0, 0), (CONV_WIDTH - 1, 0), (0, 0)))
    y = b
    for tap in range(CONV_WIDTH):
        y = y + xp[:, tap:tap + s] * w[tap]
    return y


def rg_lru(x, wx, bx, wa, ba, a_param):
    bsz, s, c = x.shape
    xb = x.reshape(bsz, s, RNN_BLOCKS, RNN_BLOCK_DIM)
    gate_x = jax.nn.sigmoid(jnp.einsum('bsgi,gij->bsgj', xb, wx).reshape(bsz, s, c) + bx)
    gate_a = jax.nn.sigmoid(jnp.einsum('bsgi,gij->bsgj', xb, wa).reshape(bsz, s, c) + ba)
    log_a = -LRU_C * gate_a.astype(jnp.float32) * jax.nn.softplus(-a_param.astype(jnp.float32))
    a = jnp.exp(log_a)
    u = jnp.sqrt(-jnp.expm1(2.0 * log_a)) * (gate_x * x).astype(jnp.float32)

    def combine(left, right):
        a_l, b_l = left
        a_r, b_r = right
        return a_l * a_r, a_r * b_l + b_r

    _, h = lax.associative_scan(combine, (a, u), axis=1)
    return h.astype(x.dtype)


def partial_rotary(x):
    s = x.shape[1]
    half = ROPE_DIM // 2
    inv_freq = ROPE_THETA ** (-jnp.arange(half, dtype=jnp.float32) * (2.0 / ROPE_DIM))
    ang = jnp.arange(s, dtype=jnp.float32)[:, None] * inv_freq[None, :]
    cos = jnp.cos(ang)[:, None, :]
    sin = jnp.sin(ang)[:, None, :]
    xf = x.astype(jnp.float32)
    x1 = xf[..., :half]
    x2 = xf[..., half:ROPE_DIM]
    out = jnp.concatenate([x1 * cos - x2 * sin, x2 * cos + x1 * sin, xf[..., ROPE_DIM:]], axis=-1)
    return out.astype(x.dtype)


def moba_attention(q, k, v):
    bsz, s, h, d = q.shape
    nb = -(-s // MOBA_BLOCK)
    s_pad = nb * MOBA_BLOCK
    topk = min(MOBA_TOPK, nb)
    scale = 1.0 / math.sqrt(d)

    def to_heads(t):
        return jnp.pad(t, ((0, 0), (0, s_pad - s), (0, 0), (0, 0))).transpose(0, 2, 1, 3)

    qh, kh, vh = to_heads(q), to_heads(k), to_heads(v)
    qb = qh.reshape(bsz, h, nb, MOBA_BLOCK, d)
    kb = kh.reshape(bsz, h, nb, MOBA_BLOCK, d)
    vb = vh.reshape(bsz, h, nb, MOBA_BLOCK, d)

    s_own = jnp.einsum('bhnqd,bhnkd->bhnqk', qb, kb).astype(jnp.float32) * scale
    causal = jnp.tril(jnp.ones((MOBA_BLOCK, MOBA_BLOCK), dtype=bool))
    s_own = jnp.where(causal, s_own, NEG)
    lse_own = jax.nn.logsumexp(s_own, axis=-1)
    p_own = jnp.exp(s_own - lse_own[..., None]).astype(vb.dtype)
    o_own = jnp.einsum('bhnqk,bhnkd->bhnqd', p_own, vb).reshape(bsz, h, s_pad, d).astype(jnp.float32)
    lse_own = lse_own.reshape(bsz, h, s_pad)

    k_mean = jnp.mean(kb.astype(jnp.float32), axis=3)
    gate = jnp.einsum('bhsd,bhnd->bhsn', qh.astype(jnp.float32), k_mean)
    q_block = jnp.arange(s_pad, dtype=jnp.int32) // MOBA_BLOCK
    past = jnp.arange(nb, dtype=jnp.int32)[None, :] < q_block[:, None]
    gate = jnp.where(past, gate, NEG)
    _, sel = lax.top_k(gate, topk)
    valid = sel < q_block[:, None]
    flat_sel = sel + (jnp.arange(bsz * h, dtype=jnp.int32) * nb).reshape(bsz, h, 1, 1)
    k_flat = kb.reshape(bsz * h * nb, MOBA_BLOCK, d)
    v_flat = vb.reshape(bsz * h * nb, MOBA_BLOCK, d)
    n_chunks = bsz * h * s_pad // Q_CHUNK

    def attend_selected(args):
        qc, ic, vc = args
        kg = k_flat[ic]
        vg = v_flat[ic]
        sc = jnp.einsum('cd,cjkd->cjk', qc, kg).astype(jnp.float32) * scale
        sc = jnp.where(vc[:, :, None], sc, NEG).reshape(Q_CHUNK, topk * MOBA_BLOCK)
        lse = jax.nn.logsumexp(sc, axis=-1)
        p = jnp.exp(sc - lse[:, None]).reshape(Q_CHUNK, topk, MOBA_BLOCK).astype(vg.dtype)
        return jnp.einsum('cjk,cjkd->cd', p, vg).astype(jnp.float32), lse

    o_sel, lse_sel = lax.map(attend_selected, (qh.reshape(n_chunks, Q_CHUNK, d),
                                               flat_sel.reshape(n_chunks, Q_CHUNK, topk),
                                               valid.reshape(n_chunks, Q_CHUNK, topk)))
    o_sel = o_sel.reshape(bsz, h, s_pad, d)
    lse_sel = lse_sel.reshape(bsz, h, s_pad)
    lse = jnp.logaddexp(lse_own, lse_sel)
    o = jnp.exp(lse_own - lse)[..., None] * o_own + jnp.exp(lse_sel - lse)[..., None] * o_sel
    return o[:, :, :s].transpose(0, 2, 1, 3).reshape(bsz, s, h * d).astype(q.dtype)


def moe_ffn(xn, router_w, router_b, w_gu, b_gu, w_down, b_down):
    bsz, s, d = xn.shape
    n_tok = bsz * s
    xt = xn.reshape(n_tok, d)
    logits = (xt @ router_w).astype(jnp.float32) + router_b.astype(jnp.float32)
    top_val, top_idx = lax.top_k(logits, TOP_K)
    gates = jax.nn.softmax(top_val, axis=-1)

    n_assign = n_tok * TOP_K
    e_flat = top_idx.reshape(-1).astype(jnp.int32)
    tok_flat = jnp.arange(n_assign, dtype=jnp.int32) // TOP_K
    w_flat = gates.reshape(-1)
    order = jnp.argsort(e_flat)
    e_s, tok_s, w_s = e_flat[order], tok_flat[order], w_flat[order]
    counts = jnp.zeros((N_EXPERTS,), jnp.int32).at[e_flat].add(1)
    start = jnp.cumsum(counts) - counts
    padded = ((counts + EXPERT_ROWS - 1) // EXPERT_ROWS) * EXPERT_ROWS
    pend = jnp.cumsum(padded)
    pstart = pend - padded
    dest = pstart[e_s] + (jnp.arange(n_assign, dtype=jnp.int32) - start[e_s])
    n_rows = n_assign + N_EXPERTS * EXPERT_ROWS
    n_blk = n_rows // EXPERT_ROWS
    row_tok = jnp.full((n_rows,), n_tok, jnp.int32).at[dest].set(tok_s)
    row_w = jnp.zeros((n_rows,), jnp.float32).at[dest].set(w_s)
    blk_start = jnp.arange(n_blk, dtype=jnp.int32) * EXPERT_ROWS
    blk_expert = jnp.minimum(jnp.sum(blk_start[:, None] >= pend[None, :], axis=1), N_EXPERTS - 1)
    x_rows = jnp.concatenate([xt, jnp.zeros((1, d), xt.dtype)], axis=0)[row_tok]
    x_rows = x_rows.reshape(n_blk, EXPERT_ROWS, d)

    def expert_block(args):
        xb, e = args
        gu = xb @ w_gu[e] + b_gu[e]
        x_glu = jnp.minimum(gu[:, :D_EXPERT], SWIGLU_LIMIT)
        x_lin = jnp.clip(gu[:, D_EXPERT:], -SWIGLU_LIMIT, SWIGLU_LIMIT)
        act = x_glu * jax.nn.sigmoid(SWIGLU_ALPHA * x_glu) * (x_lin + 1.0)
        return act @ w_down[e] + b_down[e]

    y_blocks = lax.map(expert_block, (x_rows, blk_expert))
    y_rows = y_blocks.reshape(n_rows, d) * row_w[:, None].astype(y_blocks.dtype)
    y = jax.ops.segment_sum(y_rows, row_tok, num_segments=n_tok + 1)[:n_tok]
    return y.reshape(bsz, s, d)


def setup_inputs(seed: int = 0) -> dict:
    key = jax.random.key(seed)
    ks = jax.random.split(key, 21)
    f32 = jnp.float32

    def nrm(k, shape, scale):
        return jax.random.normal(k, shape, f32) * scale

    in_cols = 2 * RNN_WIDTH + 3 * ATTN_WIDTH + 2 * D_MODEL
    u = jax.random.uniform(ks[9], (DEPTH, RNN_WIDTH), f32, minval=0.9, maxval=0.999)
    s_lam = u ** (1.0 / LRU_C)
    return {
        'x': nrm(ks[0], (BATCH, SEQ, D_MODEL), 1.0),
        'norm_mix_g': 1.0 + nrm(ks[1], (DEPTH, D_MODEL), 0.02),
        'w_in': nrm(ks[2], (DEPTH, D_MODEL, in_cols), D_MODEL ** -0.5),
        'conv_w': nrm(ks[3], (DEPTH, CONV_WIDTH, RNN_WIDTH), CONV_WIDTH ** -0.5),
        'conv_b': nrm(ks[4], (DEPTH, RNN_WIDTH), 0.01),
        'lru_wx': nrm(ks[5], (DEPTH, RNN_BLOCKS, RNN_BLOCK_DIM, RNN_BLOCK_DIM), RNN_BLOCK_DIM ** -0.5),
        'lru_bx': nrm(ks[6], (DEPTH, RNN_WIDTH), 0.01),
        'lru_wa': nrm(ks[7], (DEPTH, RNN_BLOCKS, RNN_BLOCK_DIM, RNN_BLOCK_DIM), RNN_BLOCK_DIM ** -0.5),
        'lru_ba': nrm(ks[8], (DEPTH, RNN_WIDTH), 0.01),
        'lru_a_param': jnp.log(s_lam) - jnp.log1p(-s_lam),
        'w_proj_rnn': nrm(ks[10], (DEPTH, RNN_WIDTH, D_MODEL), RNN_WIDTH ** -0.5),
        'w_proj_attn': nrm(ks[11], (DEPTH, ATTN_WIDTH, D_MODEL), ATTN_WIDTH ** -0.5),
        'w_out': nrm(ks[12], (DEPTH, D_MODEL, D_MODEL), D_MODEL ** -0.5),
        'norm_ffn_g': 1.0 + nrm(ks[13], (DEPTH, D_MODEL), 0.02),
        'router_w': nrm(ks[14], (DEPTH, D_MODEL, N_EXPERTS), D_MODEL ** -0.5),
        'router_b': nrm(ks[15], (DEPTH, N_EXPERTS), 0.01),
        'expert_w_gu': nrm(ks[16], (DEPTH, N_EXPERTS, D_MODEL, 2 * D_EXPERT), D_MODEL ** -0.5),
        'expert_b_gu': nrm(ks[17], (DEPTH, N_EXPERTS, 2 * D_EXPERT), 0.01),
        'expert_w_down': nrm(ks[18], (DEPTH, N_EXPERTS, D_EXPERT, D_MODEL), D_EXPERT ** -0.5),
        'expert_b_down': nrm(ks[19], (DEPTH, N_EXPERTS, D_MODEL), 0.01),
        'norm_final_g': 1.0 + nrm(ks[20], (D_MODEL,), 0.02),
    }


def reference(x, norm_mix_g, w_in, conv_w, conv_b, lru_wx, lru_bx, lru_wa, lru_ba, lru_a_param,
              w_proj_rnn, w_proj_attn, w_out, norm_ffn_g, router_w, router_b,
              expert_w_gu, expert_b_gu, expert_w_down, expert_b_down, norm_final_g):
    bsz, s, _ = x.shape
    splits = [RNN_WIDTH, 2 * RNN_WIDTH, 2 * RNN_WIDTH + ATTN_WIDTH, 2 * RNN_WIDTH + 2 * ATTN_WIDTH,
              2 * RNN_WIDTH + 3 * ATTN_WIDTH, 2 * RNN_WIDTH + 3 * ATTN_WIDTH + D_MODEL]
    for layer in range(DEPTH):
        xn = rms_norm(x, norm_mix_g[layer])
        z = xn @ w_in[layer]
        rnn_x, rnn_gate, q, k, v, g_rnn, g_attn = jnp.split(z, splits, axis=-1)
        xc = causal_depthwise_conv(rnn_x, conv_w[layer], conv_b[layer])
        hr = rg_lru(xc, lru_wx[layer], lru_bx[layer], lru_wa[layer], lru_ba[layer], lru_a_param[layer])
        y_rnn = (hr * jax.nn.gelu(rnn_gate)) @ w_proj_rnn[layer]
        q = partial_rotary(q.reshape(bsz, s, N_HEADS, HEAD_DIM))
        k = partial_rotary(k.reshape(bsz, s, N_HEADS, HEAD_DIM))
        v = v.reshape(bsz, s, N_HEADS, HEAD_DIM)
        y_attn = moba_attention(q, k, v) @ w_proj_attn[layer]
        mixed = jax.nn.sigmoid(g_rnn) * y_rnn + jax.nn.sigmoid(g_attn) * y_attn
        x = x + mixed @ w_out[layer]
        hn = rms_norm(x, norm_ffn_g[layer])
        x = x + moe_ffn(hn, router_w[layer], router_b[layer], expert_w_gu[layer], expert_b_gu[layer],
                        expert_w_down[layer], expert_b_down[layer])
    return rms_norm(x, norm_final_g)
```

```cpp
#include <hip/hip_runtime.h>
#include <cstdio>
#include <cstdint>

#ifndef MK_N_LAUNCHES
#define MK_N_LAUNCHES 1
#endif

#define LAS __attribute__((address_space(3)))
#define GAS __attribute__((address_space(1)))
typedef unsigned short bf16_t;
typedef short bf16x8 __attribute__((ext_vector_type(8)));
typedef short s16x4 __attribute__((ext_vector_type(4)));
typedef float f32x4 __attribute__((ext_vector_type(4)));
typedef float f32x2 __attribute__((ext_vector_type(2)));
typedef float f32x16 __attribute__((ext_vector_type(16)));
typedef unsigned u32x4 __attribute__((ext_vector_type(4)));
typedef unsigned u32x2 __attribute__((ext_vector_type(2)));
typedef GAS unsigned gu32;
#define RLX_AGENT __ATOMIC_RELAXED, __HIP_MEMORY_SCOPE_AGENT
#define LDS_WAIT() asm volatile("s_waitcnt lgkmcnt(0)" ::: "memory")
#define VM_WAIT() asm volatile("s_waitcnt vmcnt(0)" ::: "memory")

constexpr int DM = 1024, BATCH = 16, SEQ = 2048, MTOK = BATCH * SEQ;
constexpr int NIN = 7168;
constexpr int NHEAD = 8, HD = 128;
constexpr int NEXP = 32, TOPK = 4, DEXP = 1024;
constexpr int NASSIGN = MTOK * TOPK;
constexpr int MAXROWS = NASSIGN + NEXP * 256;
constexpr float EPS = 1e-6f;
constexpr int NWAVES = 8;

constexpr size_t MiB = 1u << 20;
constexpr size_t WS_CTL = 0, CTL_ZERO_BYTES = 1 * MiB;
constexpr size_t WS_R0 = 1 * MiB;
constexpr size_t WS_R1 = WS_R0 + 128 * 1024;
constexpr size_t WS_COS = WS_R1 + 128 * 1024;
constexpr size_t WS_SIN = WS_COS + 128 * 1024;
constexpr size_t WS_SP = WS_SIN + 128 * 1024;
constexpr size_t WS_KMEAN = WS_SP + 64 * 1024;
constexpr size_t WS_GW = 3 * MiB;
constexpr size_t WS_ELIST = 4 * MiB;
constexpr size_t WS_WIN = 16 * MiB;
constexpr size_t WS_WR = 30 * MiB, WS_WA = 32 * MiB, WS_WO = 34 * MiB;
constexpr size_t WS_WGU = 36 * MiB;
constexpr size_t WS_WD = 164 * MiB;
constexpr size_t WS_Z = 228 * MiB;
constexpr size_t ZSTRIDE = 64 * MiB;
constexpr size_t WS_TMP = WS_Z;
constexpr size_t WS_ACT = WS_Z;
constexpr size_t WS_X1B = WS_Z + 272 * MiB;
constexpr size_t WS_G4 = 676 * MiB;
constexpr size_t WS_XB = WS_G4, WS_HG = WS_G4 + 64 * MiB, WS_OA = WS_G4 + 128 * MiB, WS_MIX = WS_G4 + 192 * MiB;
constexpr size_t WS_CONTRIB = WS_G4;
constexpr size_t WS_END = 932 * MiB;
static_assert((size_t)MAXROWS * 2048 <= 272 * MiB, "act");
constexpr int CW_TMO = 0, CW_BAR = 4096, CW_CNT = 8192;

constexpr int RING_BYTES = 131072;
constexpr int MISC_OFF = 139264;
constexpr int LDS_BYTES = 147456;

__device__ __forceinline__ unsigned cvt_pk_bf16(float lo, float hi) { unsigned r; asm volatile("v_cvt_pk_bf16_f32 %0, %1, %2" : "=v"(r) : "v"(lo), "v"(hi)); return r; }
__device__ __forceinline__ float bf_lo(unsigned w) { return __uint_as_float(w << 16); }
__device__ __forceinline__ float bf_hi(unsigned w) { return __uint_as_float(w & 0xffff0000u); }
__device__ __forceinline__ float bf2f(bf16_t b) { return __uint_as_float(((unsigned)b) << 16); }
__device__ __forceinline__ float fast_sigmoid(float x) { return __builtin_amdgcn_rcpf(1.0f + __builtin_amdgcn_exp2f(-1.4426950408889634f * x)); }
__device__ __forceinline__ float wave_sum(float v) {
#pragma unroll
    for (int o = 1; o < 64; o <<= 1) v += __shfl_xor(v, o);
    return v;
}

#define XB_TMO      128
#define XB_XCNT(j)  (256  + 64 * (j))
#define XB_XSUB(j)  (1280 + 64 * (j))
#define XB_XGEN(j)  (2304 + 64 * (j))
#define XB_TOP      3328
#define XB_TOPGEN   3392
#define XCD_BAR_WORDS 3456
#define XB_SPIN_CAP (1u << 18)
__device__ __forceinline__ unsigned xb_ld(unsigned* p)              { return __hip_atomic_load(p, __ATOMIC_RELAXED, __HIP_MEMORY_SCOPE_AGENT); }
__device__ __forceinline__ unsigned xb_add(unsigned* p, unsigned v) { return __hip_atomic_fetch_add(p, v, __ATOMIC_RELAXED, __HIP_MEMORY_SCOPE_AGENT); }
__device__ __forceinline__ unsigned xb_xcc_id() { return (unsigned)__builtin_amdgcn_s_getreg((3 << 11) | 20) & 0xFu; }
#define XB_SPIN(cond, bar) do { unsigned _sp = 0; while (cond) { __builtin_amdgcn_s_sleep(1); \
    if ((++_sp & 255u) == 0u) { if (xb_ld(&(bar)[XB_TMO])) break; if (_sp > XB_SPIN_CAP) { atomicAdd(&(bar)[XB_TMO], 1u); break; } } } } while (0)
struct XcdBarrier { unsigned* bar; unsigned x; volatile LAS unsigned* st; };
__device__ __forceinline__ XcdBarrier xcd_barrier_post(unsigned* bar, volatile LAS unsigned* st) {
    XcdBarrier b; b.bar = bar; b.x = xb_xcc_id(); b.st = st;
    if (threadIdx.x == 0) (void)xb_add(&bar[XB_XCNT(b.x)], 1u);
    return b;
}
__device__ __forceinline__ void xcd_barrier_complete(unsigned* bar, unsigned x, unsigned& nloc, unsigned& nx) {
    const unsigned G = gridDim.x * gridDim.y * gridDim.z;
    unsigned sum, cnt, mine, sp = 0u;
    for (;;) {
        sum = 0u; cnt = 0u; mine = 0u;
#pragma unroll
        for (unsigned j = 0; j < 16; ++j) { const unsigned c = xb_ld(&bar[XB_XCNT(j)]); sum += c; cnt += (c > 0u) ? 1u : 0u; mine = (j == x) ? c : mine; }
        if (sum == G) break;
        __builtin_amdgcn_s_sleep(1);
        if ((++sp & 255u) == 0u) { if (xb_ld(&bar[XB_TMO])) break; if (sp > XB_SPIN_CAP) { atomicAdd(&bar[XB_TMO], 1u); break; } }
    }
    nloc = mine > 0u ? mine : 1u; nx = cnt > 0u ? cnt : 1u;
}
__device__ __forceinline__ void xcd_barrier(const XcdBarrier& b) {
    asm volatile("s_waitcnt vmcnt(0)" ::: "memory");
    __syncthreads();
    if (threadIdx.x == 0) {
        unsigned* bar = b.bar;
        __builtin_amdgcn_s_waitcnt(0);
        unsigned nloc = b.st[0], nx = b.st[1];
        if (nloc == 0u) { xcd_barrier_complete(bar, b.x, nloc, nx); b.st[0] = nloc; b.st[1] = nx; }
        const unsigned old = xb_add(&bar[XB_XSUB(b.x)], 1u);
        const unsigned gen = old / nloc;
        if (old + 1u == (gen + 1u) * nloc) {
            __builtin_amdgcn_fence(__ATOMIC_RELEASE, "agent");
            asm volatile("s_waitcnt vmcnt(0)" ::: "memory");
            const unsigned og = xb_add(&bar[XB_TOP], 1u);
            const unsigned tg = og / nx;
            if (og + 1u == (tg + 1u) * nx) xb_add(&bar[XB_TOPGEN], 1u);
            else XB_SPIN(xb_ld(&bar[XB_TOPGEN]) == tg, bar);
            __builtin_amdgcn_fence(__ATOMIC_ACQUIRE, "agent");
            xb_add(&bar[XB_XGEN(b.x)], 1u);
            asm volatile("s_waitcnt vmcnt(0)" ::: "memory");
        } else {
            XB_SPIN(xb_ld(&bar[XB_XGEN(b.x)]) == gen, bar);
            __builtin_amdgcn_fence(__ATOMIC_ACQUIRE, "agent");
            asm volatile("s_waitcnt vmcnt(0)" ::: "memory");
        }
    }
    __syncthreads();
}

namespace pg8 {
constexpr int BM = 256, BK = 64, HALF = 128, HTB = HALF * BK * 2, STAGE_BYTES = 8 * HTB;
__host__ __device__ __forceinline__ int lds_byte(int r, int c) { const int st = (r >> 4) * 2 + (c >> 5), rr = r & 15, cc = c & 31, ob = rr * 64 + cc * 2; return st * 1024 + (ob ^ (((ob >> 9) & 1) << 5)); }
__host__ __device__ __forceinline__ void stage_rc(int b, int& R, int& C) { const int st = b / 1024, sb = b % 1024, swz = sb ^ (((sb >> 9) & 1) << 5); R = (st >> 1) * 16 + swz / 64; C = (st & 1) * 32 + (swz % 64) / 2; }
__host__ __device__ __forceinline__ int perm32(int rho) { const int n = rho >> 4, i = rho & 15; return 8 * (i >> 2) + 4 * n + (i & 3); }

struct Unit { int pm, pn; const char* a; const char* b; int e, rbase, cnt; };

template <class Epi, class Sched, bool GATHER>
__device__ __forceinline__ void gemm_phase(LAS unsigned char* lds, const int K, const Sched& S, const Epi& E) {
    const int tid = threadIdx.x, wid = __builtin_amdgcn_readfirstlane(tid >> 6), lane = tid & 63, wr = wid >> 2, wc = wid & 3, fr = lane & 15, fq = lane >> 4;
    const int nt = K / BK;
    unsigned voffA[2], voffB[2]; int RA[2], CA[2];
#pragma unroll
    for (int i = 0; i < 2; ++i) { int R, C; stage_rc(tid * 16 + i * 8192, R, C); const int Rb = Epi::PERM ? ((R & ~31) + perm32(R & 31)) : R;
        RA[i] = R; CA[i] = C; voffA[i] = (unsigned)(R * K + C) * 2u; voffB[i] = (unsigned)(Rb * K + C) * 2u; }
    const size_t kstep = (size_t)(BK * 2);
    const size_t hstep = (size_t)HALF * K * 2;
    const unsigned ldsw = (unsigned)wid * 1024u;
    const int aoff = lds_byte(wr * 64 + fr, fq * 8), boff = lds_byte(wc * 32 + fr, fq * 8);
#define PG8_SA(b, h) (((b) * 2 + (h)) * HTB)
#define PG8_SB(b, h) ((4 + (b) * 2 + (h)) * HTB)
#define PG8_STAGE(bufoff, gbase, voff) do { _Pragma("unroll") for (int _i = 0; _i < 2; ++_i) \
        __builtin_amdgcn_global_load_lds((const unsigned*)((const char*)(gbase) + (voff)[_i]), (LAS unsigned*)(lds + (bufoff) + ldsw + _i * 8192), 16, 0, 0); } while (0)
#define PG8_STAGE_A(bufoff, base, h, useNext) do { if constexpr (GATHER) { \
        unsigned _v[2]; _v[0] = (useNext) ? gn[h][0] : gc[h][0]; _v[1] = (useNext) ? gn[h][1] : gc[h][1]; PG8_STAGE(bufoff, base, _v); } \
        else { PG8_STAGE(bufoff, (base) + (h) * hstep, voffA); } } while (0)
#define PG8_LDA(dst, b, h) do { _Pragma("unroll") for (int m = 0; m < 4; ++m) _Pragma("unroll") for (int k = 0; k < 2; ++k) dst[m][k] = *(const LAS bf16x8*)(lds + PG8_SA(b, h) + aoff + m * 2048 + k * 1024); } while (0)
#define PG8_LDB(dst, b, h) do { _Pragma("unroll") for (int n = 0; n < 2; ++n) _Pragma("unroll") for (int k = 0; k < 2; ++k) dst[n][k] = *(const LAS bf16x8*)(lds + PG8_SB(b, h) + boff + n * 2048 + k * 1024); } while (0)
#define PG8_MMA(ai, bj, At, Bt) do { __builtin_amdgcn_s_setprio(1); _Pragma("unroll") for (int m = 0; m < 4; ++m) _Pragma("unroll") for (int n = 0; n < 2; ++n) _Pragma("unroll") for (int k = 0; k < 2; ++k) \
        acc[ai][bj][m][n] = __builtin_amdgcn_mfma_f32_16x16x32_bf16(Bt[n][k], At[m][k], acc[ai][bj][m][n], 0, 0, 0); __builtin_amdgcn_s_setprio(0); } while (0)
#define PG8_WAIT_V(n) asm volatile("s_waitcnt vmcnt(" #n ")" ::: "memory")
#define PG8_WAIT_L(n) asm volatile("s_waitcnt lgkmcnt(" #n ")" ::: "memory")
#define PG8_BAR __builtin_amdgcn_s_barrier()
#define PG8_SCHED __builtin_amdgcn_sched_barrier(0)
    Unit cur, nxt; int ui = 0;
    if (!S.next(0, cur)) return;
    f32x4 acc[2][2][4][2];
#pragma unroll
    for (int a = 0; a < 2; ++a)
#pragma unroll
        for (int b = 0; b < 2; ++b)
#pragma unroll
            for (int m = 0; m < 4; ++m)
#pragma unroll
                for (int n = 0; n < 2; ++n) acc[a][b][m][n] = (f32x4){0.f, 0.f, 0.f, 0.f};
    bf16x8 At[4][2], B0[2][2], B1[2][2];
    unsigned gc[2][2] = {{0u, 0u}, {0u, 0u}}, gn[2][2] = {{0u, 0u}, {0u, 0u}};
    if constexpr (GATHER) { S.rows(cur, RA, CA, gc); gn[0][0] = gc[0][0]; gn[0][1] = gc[0][1]; gn[1][0] = gc[1][0]; gn[1][1] = gc[1][1]; }
    const char* cA = cur.a; const char* cB = cur.b;
    PG8_STAGE(PG8_SB(0, 0), cB, voffB); PG8_STAGE_A(PG8_SA(0, 0), cA, 0, false); PG8_STAGE(PG8_SB(0, 1), cB + hstep, voffB); PG8_STAGE_A(PG8_SA(0, 1), cA, 1, false);
    if (wr == 1) PG8_BAR;
    PG8_WAIT_V(4); PG8_BAR;
    PG8_STAGE(PG8_SB(1, 0), cB + kstep, voffB); PG8_STAGE_A(PG8_SA(1, 0), cA + kstep, 0, false); PG8_STAGE(PG8_SB(1, 1), cB + hstep + kstep, voffB);
    PG8_WAIT_V(6); PG8_BAR;
    for (;;) {
        const bool has_next = S.next(ui + 1, nxt);
        const char* nA = has_next ? nxt.a : cA; const char* nB = has_next ? nxt.b : cB;
        for (int t = 0; t < nt; t += 2) {
            const bool last = (t == nt - 2);
            const char* a1 = cA + (size_t)(t + 1) * kstep;
            const char* a2 = last ? nA : cA + (size_t)(t + 2) * kstep; const char* b2 = last ? nB : cB + (size_t)(t + 2) * kstep;
            const char* a3 = a2 + kstep; const char* b3 = b2 + kstep;
            if constexpr (GATHER) { if (last && has_next) S.rows(nxt, RA, CA, gn); }
            PG8_LDB(B0, 0, 0); PG8_SCHED; PG8_LDA(At, 0, 0); PG8_STAGE_A(PG8_SA(1, 1), a1, 1, false);
            PG8_WAIT_L(8); PG8_BAR; PG8_WAIT_L(0); PG8_MMA(0, 0, At, B0); PG8_BAR; PG8_SCHED;
            PG8_LDB(B1, 0, 1); PG8_STAGE(PG8_SB(0, 0), b2, voffB);
            PG8_BAR; PG8_WAIT_L(0); PG8_MMA(0, 1, At, B1); PG8_BAR;
            PG8_LDA(At, 0, 1); PG8_STAGE_A(PG8_SA(0, 0), a2, 0, last);
            PG8_BAR; PG8_WAIT_L(0); PG8_MMA(1, 0, At, B0); PG8_BAR; PG8_SCHED;
            PG8_STAGE(PG8_SB(0, 1), b2 + hstep, voffB);
            PG8_WAIT_V(6); PG8_BAR; PG8_MMA(1, 1, At, B1); PG8_BAR;
            PG8_LDB(B0, 1, 0); PG8_SCHED; PG8_LDA(At, 1, 0); PG8_STAGE_A(PG8_SA(0, 1), a2, 1, last);
            PG8_WAIT_L(8); PG8_BAR; PG8_WAIT_L(0); PG8_MMA(0, 0, At, B0); PG8_BAR; PG8_SCHED;
            PG8_LDB(B1, 1, 1); PG8_STAGE(PG8_SB(1, 0), b3, voffB);
            PG8_BAR; PG8_WAIT_L(0); PG8_MMA(0, 1, At, B1); PG8_BAR;
            PG8_LDA(At, 1, 1); PG8_STAGE_A(PG8_SA(1, 0), a3, 0, last);
            PG8_BAR; PG8_WAIT_L(0); PG8_MMA(1, 0, At, B0); PG8_BAR; PG8_SCHED;
            PG8_STAGE(PG8_SB(1, 1), b3 + hstep, voffB);
            PG8_WAIT_V(6); PG8_BAR; PG8_MMA(1, 1, At, B1); PG8_BAR;
        }
        E(acc, cur, wr, wc, fr, fq);
        if (!has_next) break;
#pragma unroll
        for (int a = 0; a < 2; ++a)
#pragma unroll
            for (int b = 0; b < 2; ++b)
#pragma unroll
                for (int m = 0; m < 4; ++m)
#pragma unroll
                    for (int n = 0; n < 2; ++n) acc[a][b][m][n] = (f32x4){0.f, 0.f, 0.f, 0.f};
        cur = nxt; cA = nA; cB = nB; ++ui;
        if constexpr (GATHER) { gc[0][0] = gn[0][0]; gc[0][1] = gn[0][1]; gc[1][0] = gn[1][0]; gc[1][1] = gn[1][1]; }
    }
    PG8_WAIT_V(0);
    if (wr == 0) PG8_BAR;
    PG8_BAR;
#undef PG8_SA
#undef PG8_SB
#undef PG8_STAGE
#undef PG8_STAGE_A
#undef PG8_LDA
#undef PG8_LDB
#undef PG8_MMA
#undef PG8_WAIT_V
#undef PG8_WAIT_L
#undef PG8_BAR
#undef PG8_SCHED
}

struct DenseOrder {
    const char* A; const char* Bt; int nM, nN, K, G, vcu;
    __device__ __forceinline__ bool next(int i, Unit& u) const {
        int pm, pn;
        if (G == 256 && (nM % 64) == 0 && (nN % 4) == 0) {
            const int x = vcu >> 5, w = vcu & 31, ncg = nN >> 2, rg = i / ncg, cg = i - rg * ncg, rpx = nM >> 3;
            if (rg * 8 >= rpx) return false;
            pm = x * rpx + rg * 8 + (w & 7); pn = cg * 4 + (w >> 3);
        } else { const int L = i * G + vcu; if (L >= nM * nN) return false; pm = L / nN; pn = L - pm * nN; }
        u.pm = pm; u.pn = pn; u.a = A + (size_t)pm * 256 * K * 2; u.b = Bt + (size_t)pn * 256 * K * 2; u.e = 0; u.rbase = 0; u.cnt = 0;
        return true;
    }
};
struct MoeOrder {
    const LAS int* tstart;
    const LAS int* ecnt;
    const char* A; const char* Bt; size_t bstride; const int* elist; int nN, K, G, vcu; bool gatherA;
    __device__ __forceinline__ bool next(int i, Unit& u) const {
        const int L = i * G + vcu, gt = L / nN, pn = L - gt * nN;
        const int total = tstart[32];
        if (gt >= total) { LDS_WAIT(); return false; }
        int e = 0;
#pragma unroll 1
        for (int k = 1; k < 32; ++k) e += (tstart[k] <= gt) ? 1 : 0;
        const int rb = (gt - tstart[e]) * 256, c = ecnt[e];
        LDS_WAIT();
        u.pm = gt; u.pn = pn; u.e = __builtin_amdgcn_readfirstlane(e); u.rbase = __builtin_amdgcn_readfirstlane(rb); u.cnt = __builtin_amdgcn_readfirstlane(c);
        u.a = gatherA ? A : A + (size_t)gt * 256 * K * 2;
        u.b = Bt + (size_t)u.e * bstride + (size_t)pn * 256 * K * 2;
        return true;
    }
    __device__ __forceinline__ void rows(const Unit& u, const int (&RA)[2], const int (&CA)[2], unsigned (&g)[2][2]) const {
#pragma unroll
        for (int h = 0; h < 2; ++h)
#pragma unroll
            for (int i = 0; i < 2; ++i) { int r = u.rbase + RA[i] + 128 * h; r = r < u.cnt ? r : u.cnt - 1;
                const int id = elist[(size_t)u.e * MTOK + r]; g[h][i] = (unsigned)(id >> 2) * (unsigned)(K * 2) + (unsigned)(CA[i] * 2); }
    }
};
}

namespace att {
constexpr int D = 128, LDP = 1024;
constexpr float SCALE = 0.08838834764831845f;
constexpr float THR = 8.f;
constexpr int NW = 8, QBLK = 32, KVBLK = 64, QB = NW * QBLK;
constexpr int SHM_V = KVBLK * D * 2, SHM_K = KVBLK * D * 2;
constexpr int LDS_BYTES = 2 * SHM_V + 2 * SHM_K + NW * 64 * 4;
#define KSWZ(row, colB) ((row) * 256 + ((colB) ^ (((row) & 7) << 4)))
#define SBAR() __builtin_amdgcn_sched_barrier(0)
__device__ __forceinline__ int v_st(int k, int c) { const int kk = (k & ~0xC) | ((k & 4) << 1) | ((k & 8) >> 1); return ((kk >> 3) * 4 + (c >> 5)) * 512 + ((kk & 7) * 32 + (c & 31)) * 2; }
__device__ __forceinline__ int v_rd_base(int lane) { return ((lane & 3) << 3) | (((lane >> 2) & 3) << 6) | (((lane >> 4) & 1) << 5) | (((lane >> 5) & 1) << 8); }
constexpr int v_rd_off(int d0, int ks, int half) { return d0 * 512 + ks * 4096 + half * 2048; }
__device__ __forceinline__ int crow(int r, int hi) { return (r & 3) + 8 * (r >> 2) + 4 * hi; }
__device__ __forceinline__ unsigned cvtpk(float lo, float hi) { unsigned r; asm volatile("v_cvt_pk_bf16_f32 %0, %1, %2" : "=v"(r) : "v"(lo), "v"(hi)); return r; }
__device__ __forceinline__ bf16x8 load8(const bf16_t* p) { return *reinterpret_cast<const bf16x8*>(p); }
__device__ __forceinline__ void mask_tile(f32x16& p0, f32x16& p1, int dq) {
    const float NEG = -__builtin_inff();
#pragma unroll
    for (int r = 0; r < 16; ++r) {
        const int c = (r & 3) + 8 * (r >> 2);
        if (dq - c < 0) p0[r] = NEG;
        if (dq - c - 32 < 0) p1[r] = NEG;
    }
}
__device__ __forceinline__ void mask_all(f32x16& p0, f32x16& p1, bool drop) {
    const float NEG = -__builtin_inff();
#pragma unroll
    for (int r = 0; r < 16; ++r) { p0[r] = drop ? NEG : p0[r]; p1[r] = drop ? NEG : p1[r]; }
}
__device__ __forceinline__ void partialSM(f32x16& p0, f32x16& p1, float& m_reg, float& mn, float& alpha) {
    float pmax = p0[0]; for (int r = 1; r < 16; ++r) pmax = fmaxf(pmax, p0[r]); for (int r = 0; r < 16; ++r) pmax = fmaxf(pmax, p1[r]);
    { auto rr = __builtin_amdgcn_permlane32_swap(__float_as_uint(pmax), __float_as_uint(pmax), false, false);
      pmax = fmaxf(__uint_as_float(rr[0]), __uint_as_float(rr[1])); }
    constexpr float C2 = 1.4426950408889634f * SCALE;
    if (__builtin_expect(__all((pmax - m_reg) * SCALE <= THR), 1)) { mn = m_reg; alpha = 1.f; }
    else { mn = fmaxf(m_reg, pmax); alpha = __builtin_amdgcn_exp2f((m_reg - mn) * C2); m_reg = mn; }
    const float mnL = -mn * C2;
    for (int r = 0; r < 16; ++r) p0[r] = fmaf(p0[r], C2, mnL); for (int r = 0; r < 16; ++r) p1[r] = fmaf(p1[r], C2, mnL);
    for (int r = 0; r < 16; ++r) p0[r] = __builtin_amdgcn_exp2f(p0[r]);
}
__device__ __forceinline__ void finishSM(f32x16& p0, f32x16& p1, float alpha, float& l_reg, bf16x8& pa0, bf16x8& pa1, bf16x8& pa2, bf16x8& pa3) {
    for (int r = 0; r < 16; ++r) p1[r] = __builtin_amdgcn_exp2f(p1[r]);
    float ps = 0; for (int r = 0; r < 16; ++r) ps += p0[r]; for (int r = 0; r < 16; ++r) ps += p1[r];
    { auto rr = __builtin_amdgcn_permlane32_swap(__float_as_uint(ps), __float_as_uint(ps), false, false);
      ps = __uint_as_float(rr[0]) + __uint_as_float(rr[1]); }
    l_reg = l_reg * alpha + ps;
#define PK4(P, B_, OUT) do { unsigned a0 = cvtpk(P[B_+0], P[B_+1]), a1 = cvtpk(P[B_+2], P[B_+3]);                          \
        unsigned b0 = cvtpk(P[B_+4], P[B_+5]), b1 = cvtpk(P[B_+6], P[B_+7]);                                             \
        auto r0 = __builtin_amdgcn_permlane32_swap(a0, b0, false, false); auto r1 = __builtin_amdgcn_permlane32_swap(a1, b1, false, false); \
        u32x4 w = {r0[0], r1[0], r0[1], r1[1]}; OUT = *reinterpret_cast<bf16x8*>(&w); } while (0)
    PK4(p0, 0, pa0); PK4(p0, 8, pa1); PK4(p1, 0, pa2); PK4(p1, 8, pa3);
#undef PK4
}
template <int KB>
__device__ __forceinline__ void qkt(f32x16& p0, f32x16& p1, const char* K_lds, int r32, int hi, const bf16x8* qr) {
    p0 = f32x16{}; p1 = f32x16{};
    const char* kb[4];
#pragma unroll
    for (int dd = 0; dd < 4; ++dd) kb[dd] = K_lds + KB * SHM_K + KSWZ(r32, (dd * 16 + hi * 8) * 2);
#pragma unroll
    for (int d0 = 0; d0 < 8; ++d0) { const char* a = kb[d0 & 3] + (d0 >> 2) * 128;
        bf16x8 b0 = *reinterpret_cast<const bf16x8*>(a);
        bf16x8 b1 = *reinterpret_cast<const bf16x8*>(a + 32 * 256);
        p0 = __builtin_amdgcn_mfma_f32_32x32x16_bf16(b0, qr[d0], p0, 0, 0, 0);
        p1 = __builtin_amdgcn_mfma_f32_32x32x16_bf16(b1, qr[d0], p1, 0, 0, 0); }
}
template <int VB>
__device__ __forceinline__ void pv_tile(f32x16* o, int vb0, bf16x8 pa0, bf16x8 pa1, bf16x8 pa2, bf16x8 pa3) {
#define TRRD(dst, off) asm volatile("ds_read_b64_tr_b16 %0, %1 offset:%2" : "=&v"(dst) : "v"(vb0), "i"(off) : "memory")
#define PV_D0(d0) do { s16x4 l0, l1, l2, l3, h0, h1, h2, h3; constexpr int b_ = VB * SHM_V + v_rd_off(d0, 0, 0); \
        TRRD(l0, b_); TRRD(h0, b_ + 2048); TRRD(l1, b_ + 4096); TRRD(h1, b_ + 6144); TRRD(l2, b_ + 8192); TRRD(h2, b_ + 10240); TRRD(l3, b_ + 12288); TRRD(h3, b_ + 14336); \
        asm volatile("s_waitcnt lgkmcnt(0)" ::: "memory"); SBAR();   \
        o[d0] = __builtin_amdgcn_mfma_f32_32x32x16_bf16(pa0, (bf16x8){l0[0], l0[1], l0[2], l0[3], h0[0], h0[1], h0[2], h0[3]}, o[d0], 0, 0, 0);   \
        o[d0] = __builtin_amdgcn_mfma_f32_32x32x16_bf16(pa1, (bf16x8){l1[0], l1[1], l1[2], l1[3], h1[0], h1[1], h1[2], h1[3]}, o[d0], 0, 0, 0);   \
        o[d0] = __builtin_amdgcn_mfma_f32_32x32x16_bf16(pa2, (bf16x8){l2[0], l2[1], l2[2], l2[3], h2[0], h2[1], h2[2], h2[3]}, o[d0], 0, 0, 0);   \
        o[d0] = __builtin_amdgcn_mfma_f32_32x32x16_bf16(pa3, (bf16x8){l3[0], l3[1], l3[2], l3[3], h3[0], h3[1], h3[2], h3[3]}, o[d0], 0, 0, 0); } while (0)
    PV_D0(0); PV_D0(1); PV_D0(2); PV_D0(3);
#undef PV_D0
#undef TRRD
}
struct BlockRef { const bf16_t* Q; const bf16_t* K; const bf16_t* V; bf16_t* O; const float* km; int nb; };
struct Seam { bf16x8 qr[8]; bf16x8 st_v0, st_v1, st_k0, st_k1; };
#define ROW(p, k0, rr) ((p) + (size_t)((k0) + (rr)) * LDP + sc)
#define VMWN(n) asm volatile("s_waitcnt vmcnt(%0)" :: "i"(n) : "memory")
#define SLOAD_H(Kp, Vp, k0) do { S.st_v0 = load8(ROW(Vp, k0, sr)); S.st_v1 = load8(ROW(Vp, k0, 32 + sr));              \
                         S.st_k0 = load8(ROW(Kp, k0, sr)); S.st_k1 = load8(ROW(Kp, k0, 32 + sr)); } while (0)
#define SWRITE_HK(bf) do { *(bf16x8*)(K_lds + (bf) * SHM_K + kws) = S.st_k0; *(bf16x8*)(K_lds + (bf) * SHM_K + kws + 32 * 256) = S.st_k1; } while (0)
#define SWRITE_HV(bf) do { *(bf16x8*)(V_lds + (bf) * SHM_V + vst0) = S.st_v0; *(bf16x8*)(V_lds + (bf) * SHM_V + vst1) = S.st_v1; } while (0)
#define SWRITE_H(bf) do { SWRITE_HV(bf); SWRITE_HK(bf); } while (0)
__device__ __forceinline__ void moba_prime(const BlockRef& cur, char* lds, Seam& S) {
    const int tid = threadIdx.x, wid = __builtin_amdgcn_readfirstlane(tid >> 6), lane = tid & 63, r32 = lane & 31, hi = lane >> 5;
    const int sr = tid >> 4, sc = (tid & 15) * 8, kws = KSWZ(sr, sc * 2); char* K_lds = lds + 2 * SHM_V;
    for (int d0 = 0; d0 < 8; ++d0) S.qr[d0] = load8(cur.Q + (size_t)(wid * QBLK + r32) * LDP + d0 * 16 + hi * 8);
    SLOAD_H(cur.K, cur.V, 0); VM_WAIT(); SWRITE_HK(0);
    __syncthreads();
}
__device__ __forceinline__ void moba_block(const BlockRef& cur, const BlockRef& nxt, char* lds, Seam& S) {
    const int tid = threadIdx.x, wid = __builtin_amdgcn_readfirstlane(tid >> 6), lane = tid & 63, r32 = lane & 31, hi = lane >> 5;
    const int P0 = cur.nb * QB;
    const int NT = (P0 + QB) / KVBLK;
    const int qlo = P0 + wid * QBLK, qm = qlo + r32 - 4 * hi;
    char* V_lds = lds; char* K_lds = lds + 2 * SHM_V;
    float* ws = (float*)(lds + 2 * SHM_V + 2 * SHM_K) + wid * 64; float* li_l = ws, * al_l = ws + 32;
    float m_reg = -1e30f, l_reg = 0; f32x16 o[4] = {};
    const int sr = tid >> 4, sc = (tid & 15) * 8, vst0 = v_st(sr, sc), vst1 = v_st(32 + sr, sc), kws = KSWZ(sr, sc * 2);
    const int vb0 = (int)(uintptr_t)V_lds + v_rd_base(lane);
    const bf16_t* Kh = cur.K; const bf16_t* Vh = cur.V;
    unsigned selbits = 0xffu; const bool needsel = cur.nb >= 4;
    if (needsel) {
        float g[7];
#pragma unroll
        for (int j = 0; j < 7; ++j) {
            float s = 0.f;
            if (j < cur.nb) {
#pragma unroll
                for (int d0 = 0; d0 < 8; ++d0) {
                    const f32x4 k0 = *(const f32x4*)(cur.km + j * 128 + d0 * 16 + hi * 8), k1 = *(const f32x4*)(cur.km + j * 128 + d0 * 16 + hi * 8 + 4);
                    const u32x4 qw = *reinterpret_cast<const u32x4*>(&S.qr[d0]);
                    s += bf_lo(qw.x) * k0[0] + bf_hi(qw.x) * k0[1] + bf_lo(qw.y) * k0[2] + bf_hi(qw.y) * k0[3]
                       + bf_lo(qw.z) * k1[0] + bf_hi(qw.z) * k1[1] + bf_lo(qw.w) * k1[2] + bf_hi(qw.w) * k1[3];
                }
                auto rr = __builtin_amdgcn_permlane32_swap(__float_as_uint(s), __float_as_uint(s), false, false);
                s = __uint_as_float(rr[0]) + __uint_as_float(rr[1]);
            } else s = -3.0e38f;
            g[j] = s;
        }
        selbits = 0u;
#pragma unroll
        for (int j = 0; j < 7; ++j) { int rank = 0;
#pragma unroll
            for (int k = 0; k < 7; ++k) if (k != j) rank += (g[k] > g[j] || (g[k] == g[j] && k < j)) ? 1 : 0;
            if (rank < 3 && j < cur.nb) selbits |= 1u << j; }
    }
#define RESC(a) do { if (__any((a) < 1.f)) { if (hi == 0) al_l[r32] = (a); asm volatile("s_waitcnt lgkmcnt(0)" ::: "memory");              \
                     for (int d_ = 0; d_ < 4; ++d_) for (int r = 0; r < 16; ++r) o[d_][r] *= al_l[crow(r, hi)]; } } while (0)
#define KBASE(t) ((t) * KVBLK)
#define MASKT(P0_, P1_, t) do { const int kb_ = KBASE(t); \
        if (kb_ >= P0) { if (kb_ + KVBLK - 1 > qlo) mask_tile(P0_, P1_, qm - kb_); } \
        else if (needsel) { mask_all(P0_, P1_, ((selbits >> (kb_ >> 8)) & 1u) == 0u); } } while (0)
    constexpr int NQL = 8;
#define SEAM_K0() do { VMWN(NQL); SWRITE_HK(0); SBAR(); } while (0)
    f32x16 pA0, pA1, pB0, pB1; float mnA, mnB, alA, alB; bf16x8 pa0, pa1, pa2, pa3;
    SWRITE_HV(0); SBAR();
    if (NT > 1) { SLOAD_H(Kh, Vh, KBASE(1)); }
    SBAR(); qkt<0>(pA0, pA1, K_lds, r32, hi, S.qr);
    MASKT(pA0, pA1, 0); partialSM(pA0, pA1, m_reg, mnA, alA);
    if (NT > 1) { VM_WAIT(); SWRITE_H(1); }
    __syncthreads();
#define HALF_STEP(PX0, PX1, mnX, alX, PY0, PY1, alY, t, KB, VB, SB) do {                                                      \
        SBAR(); qkt<KB>(PX0, PX1, K_lds, r32, hi, S.qr);                                                                      \
        finishSM(PY0, PY1, alY, l_reg, pa0, pa1, pa2, pa3); SBAR();                                                           \
        if ((t) + 1 < NT) { SLOAD_H(Kh, Vh, KBASE((t) + 1)); SBAR(); }                                                        \
        pv_tile<VB>(o, vb0, pa0, pa1, pa2, pa3); MASKT(PX0, PX1, (t)); partialSM(PX0, PX1, m_reg, mnX, alX);                  \
        __syncthreads();                                                                                                      \
        if ((t) + 1 < NT) { VM_WAIT(); SWRITE_H(SB); }                                                                        \
        RESC(alX); __syncthreads(); } while (0)
    for (int t = 1; t + 1 < NT; t += 2) {
        HALF_STEP(pB0, pB1, mnB, alB, pA0, pA1, alA, t, 1, 0, 0);
        HALF_STEP(pA0, pA1, mnA, alA, pB0, pB1, alB, t + 1, 0, 1, 1);
    }
    SBAR(); qkt<1>(pB0, pB1, K_lds, r32, hi, S.qr); SBAR();
    SLOAD_H(nxt.K, nxt.V, 0); SBAR();
#pragma unroll
    for (int d0 = 0; d0 < 8; ++d0) S.qr[d0] = load8(nxt.Q + (size_t)(wid * QBLK + r32) * LDP + d0 * 16 + hi * 8);
    SBAR();
    finishSM(pA0, pA1, alA, l_reg, pa0, pa1, pa2, pa3); SBAR();
    pv_tile<0>(o, vb0, pa0, pa1, pa2, pa3);
    MASKT(pB0, pB1, NT - 1); partialSM(pB0, pB1, m_reg, mnB, alB); __syncthreads(); RESC(alB);
    finishSM(pB0, pB1, alB, l_reg, pa0, pa1, pa2, pa3); SBAR(); pv_tile<1>(o, vb0, pa0, pa1, pa2, pa3);
    SBAR(); SEAM_K0();
    if (hi == 0) li_l[r32] = l_reg; asm volatile("s_waitcnt lgkmcnt(0)" ::: "memory");
    float rli[16];
#pragma unroll
    for (int r = 0; r < 16; ++r) rli[r] = __builtin_amdgcn_rcpf(li_l[crow(r, hi)]);
    char* pl = (char*)(cur.O + (size_t)(wid * QBLK + 4 * hi) * LDP + r32);
    asm volatile("" : "+v"(pl));
#pragma unroll
    for (int r = 0; r < 16; ++r) { const int orow0 = (r & 3) + 8 * (r >> 2);
#pragma unroll
        for (int d0 = 0; d0 < 4; ++d0) { const float v = o[d0][r] * rli[r];
            const float vn = __shfl_xor(v, 1);
            if ((r32 & 1) == 0) *(unsigned*)(pl + (size_t)orow0 * LDP * 2 + d0 * 64) = cvtpk(v, vn); } }
    __syncthreads();
#undef RESC
#undef KBASE
#undef MASKT
#undef SEAM_K0
#undef HALF_STEP
}
#undef ROW
#undef VMWN
#undef SLOAD_H
#undef SWRITE_HK
#undef SWRITE_HV
#undef SWRITE_H
}

struct EpiIn {
    static constexpr bool PERM = true;
    bf16_t* Z; const float* r0; const float* cosT; const float* sinT;
    __device__ __forceinline__ void operator()(f32x4 (&acc)[2][2][4][2], const pg8::Unit& u, int wr, int wc, int fr, int fq) const {
        const int type = u.pn >> 2;
        bf16_t* base = Z + (size_t)type * (ZSTRIDE / 2);
        const int colt = (u.pn & 3) * 256 + wc * 32 + 8 * fq;
        const int row0 = u.pm * 256 + wr * 64 + fr;
        const bool rot = (type == 2 || type == 3) && wc == 0;
#pragma unroll
        for (int ai = 0; ai < 2; ++ai)
#pragma unroll
            for (int m = 0; m < 4; ++m) {
                const int row = row0 + ai * 128 + m * 16; const float rs = r0[row];
                f32x4 v[2][2];
#pragma unroll
                for (int bj = 0; bj < 2; ++bj)
#pragma unroll
                    for (int n = 0; n < 2; ++n) v[bj][n] = acc[ai][bj][m][n] * rs;
                if (type == 1) {
#pragma unroll
                    for (int bj = 0; bj < 2; ++bj)
#pragma unroll
                        for (int n = 0; n < 2; ++n)
#pragma unroll
                            for (int j = 0; j < 4; ++j) { const float x = v[bj][n][j]; v[bj][n][j] = x * fast_sigmoid(1.5957691216057308f * (x + 0.044715f * x * x * x)); }
                } else if (type >= 5) {
#pragma unroll
                    for (int bj = 0; bj < 2; ++bj)
#pragma unroll
                        for (int n = 0; n < 2; ++n)
#pragma unroll
                            for (int j = 0; j < 4; ++j) v[bj][n][j] = fast_sigmoid(v[bj][n][j]);
                } else if (rot) {
                    const int pos = row & (SEQ - 1);
#pragma unroll
                    for (int n = 0; n < 2; ++n) {
                        const int i0 = (8 * fq + 4 * n) & 15;
                        const f32x4 c = *(const f32x4*)(cosT + pos * 16 + i0), s = *(const f32x4*)(sinT + pos * 16 + i0);
#pragma unroll
                        for (int bj = 0; bj < 2; ++bj)
#pragma unroll
                            for (int j = 0; j < 4; ++j) { const float mine = v[bj][n][j], other = __shfl_xor(mine, 32);
                                v[bj][n][j] = (fq < 2) ? (mine * c[j] - other * s[j]) : (mine * c[j] + other * s[j]); }
                    }
                }
                bf16_t* rowp = base + (size_t)row * 1024 + colt;
#pragma unroll
                for (int bj = 0; bj < 2; ++bj) { u32x4 w; w.x = cvt_pk_bf16(v[bj][0][0], v[bj][0][1]); w.y = cvt_pk_bf16(v[bj][0][2], v[bj][0][3]); w.z = cvt_pk_bf16(v[bj][1][0], v[bj][1][1]); w.w = cvt_pk_bf16(v[bj][1][2], v[bj][1][3]);
                    *(u32x4*)(rowp + bj * 128) = w; }
            }
    }
};
struct EpiProjRnn {
    static constexpr bool PERM = false;
    float* T; const bf16_t* S1;
    __device__ __forceinline__ void operator()(f32x4 (&acc)[2][2][4][2], const pg8::Unit& u, int wr, int wc, int fr, int fq) const {
        const int row0 = u.pm * 256 + wr * 64 + fr, col0 = u.pn * 256 + wc * 32 + 4 * fq;
#pragma unroll
        for (int ai = 0; ai < 2; ++ai)
#pragma unroll
            for (int m = 0; m < 4; ++m) { const size_t off = (size_t)(row0 + ai * 128 + m * 16) * 1024 + col0;
#pragma unroll
                for (int bj = 0; bj < 2; ++bj)
#pragma unroll
                    for (int n = 0; n < 2; ++n) { const u32x2 sw = *(const u32x2*)(S1 + off + bj * 128 + n * 16);
                        f32x4 a = acc[ai][bj][m][n]; a[0] *= bf_lo(sw.x); a[1] *= bf_hi(sw.x); a[2] *= bf_lo(sw.y); a[3] *= bf_hi(sw.y);
                        *(f32x4*)(T + off + bj * 128 + n * 16) = a; } }
    }
};
struct EpiProjAttn {
    static constexpr bool PERM = false;
    const float* T; const bf16_t* S2; bf16_t* MIX;
    __device__ __forceinline__ void operator()(f32x4 (&acc)[2][2][4][2], const pg8::Unit& u, int wr, int wc, int fr, int fq) const {
        const int row0 = u.pm * 256 + wr * 64 + fr, col0 = u.pn * 256 + wc * 32 + 4 * fq;
#pragma unroll
        for (int ai = 0; ai < 2; ++ai)
#pragma unroll
            for (int m = 0; m < 4; ++m) { const size_t off = (size_t)(row0 + ai * 128 + m * 16) * 1024 + col0;
#pragma unroll
                for (int bj = 0; bj < 2; ++bj)
#pragma unroll
                    for (int n = 0; n < 2; ++n) { const u32x2 sw = *(const u32x2*)(S2 + off + bj * 128 + n * 16); const f32x4 t = *(const f32x4*)(T + off + bj * 128 + n * 16);
                        const f32x4 a = acc[ai][bj][m][n];
                        u32x2 w; w.x = cvt_pk_bf16(t[0] + a[0] * bf_lo(sw.x), t[1] + a[1] * bf_hi(sw.x)); w.y = cvt_pk_bf16(t[2] + a[2] * bf_lo(sw.y), t[3] + a[3] * bf_hi(sw.y));
                        *(u32x2*)(MIX + off + bj * 128 + n * 16) = w; } }
    }
};
struct EpiOut {
    static constexpr bool PERM = false;
    const float* X; float* X1; bf16_t* X1B;
    __device__ __forceinline__ void operator()(f32x4 (&acc)[2][2][4][2], const pg8::Unit& u, int wr, int wc, int fr, int fq) const {
        const int row0 = u.pm * 256 + wr * 64 + fr, col0 = u.pn * 256 + wc * 32 + 4 * fq;
#pragma unroll
        for (int ai = 0; ai < 2; ++ai)
#pragma unroll
            for (int m = 0; m < 4; ++m) { const size_t off = (size_t)(row0 + ai * 128 + m * 16) * 1024 + col0;
#pragma unroll
                for (int bj = 0; bj < 2; ++bj)
#pragma unroll
                    for (int n = 0; n < 2; ++n) { const f32x4 xv = *(const f32x4*)(X + off + bj * 128 + n * 16); const f32x4 o = xv + acc[ai][bj][m][n];
                        *(f32x4*)(X1 + off + bj * 128 + n * 16) = o;
                        u32x2 w; w.x = cvt_pk_bf16(o[0], o[1]); w.y = cvt_pk_bf16(o[2], o[3]); *(u32x2*)(X1B + off + bj * 128 + n * 16) = w; } }
    }
};
struct EpiGu {
    static constexpr bool PERM = true;
    bf16_t* ACT; const float* bgu; const float* r1; const int* elist;
    __device__ __forceinline__ void operator()(f32x4 (&acc)[2][2][4][2], const pg8::Unit& u, int wr, int wc, int fr, int fq) const {
        const int c0 = u.pn * 128 + wc * 32 + 8 * fq;
        const float* bg = bgu + (size_t)u.e * 2048 + c0;
        f32x4 bgl[2], bln[2];
#pragma unroll
        for (int n = 0; n < 2; ++n) { bgl[n] = *(const f32x4*)(bg + 4 * n); bln[n] = *(const f32x4*)(bg + 1024 + 4 * n); }
#pragma unroll
        for (int ai = 0; ai < 2; ++ai)
#pragma unroll
            for (int m = 0; m < 4; ++m) {
                const int rt = ai * 128 + wr * 64 + m * 16 + fr; int r = u.rbase + rt; r = r < u.cnt ? r : u.cnt - 1;
                const int id = elist[(size_t)u.e * MTOK + r]; const float rs = r1[id >> 2];
                float a8[8];
#pragma unroll
                for (int n = 0; n < 2; ++n)
#pragma unroll
                    for (int j = 0; j < 4; ++j) { float g = acc[ai][0][m][n][j] * rs + bgl[n][j], l = acc[ai][1][m][n][j] * rs + bln[n][j];
                        g = fminf(g, 7.0f); l = fminf(fmaxf(l, -7.0f), 7.0f);
                        a8[4 * n + j] = g * fast_sigmoid(1.702f * g) * (l + 1.0f); }
                u32x4 w; w.x = cvt_pk_bf16(a8[0], a8[1]); w.y = cvt_pk_bf16(a8[2], a8[3]); w.z = cvt_pk_bf16(a8[4], a8[5]); w.w = cvt_pk_bf16(a8[6], a8[7]);
                *(u32x4*)(ACT + (size_t)(u.pm * 256 + rt) * 1024 + c0) = w;
            }
    }
};
struct EpiDown {
    static constexpr bool PERM = true;
    bf16_t* CON; const float* bd; const float* gw; const int* elist;
    __device__ __forceinline__ void operator()(f32x4 (&acc)[2][2][4][2], const pg8::Unit& u, int wr, int wc, int fr, int fq) const {
        const int c0 = u.pn * 256 + wc * 32 + 8 * fq;
        const float* bp = bd + (size_t)u.e * 1024 + c0;
        f32x4 bv[2][2];
#pragma unroll
        for (int bj = 0; bj < 2; ++bj)
#pragma unroll
            for (int n = 0; n < 2; ++n) bv[bj][n] = *(const f32x4*)(bp + bj * 128 + 4 * n);
#pragma unroll
        for (int ai = 0; ai < 2; ++ai)
#pragma unroll
            for (int m = 0; m < 4; ++m) {
                const int r = u.rbase + ai * 128 + wr * 64 + m * 16 + fr;
                if (r < u.cnt) {
                    const int id = elist[(size_t)u.e * MTOK + r]; const float w8 = gw[id];
                    bf16_t* rowp = CON + (size_t)id * 1024 + c0;
#pragma unroll
                    for (int bj = 0; bj < 2; ++bj) { const f32x4 v0 = (acc[ai][bj][m][0] + bv[bj][0]) * w8, v1 = (acc[ai][bj][m][1] + bv[bj][1]) * w8;
                        u32x4 w; w.x = cvt_pk_bf16(v0[0], v0[1]); w.y = cvt_pk_bf16(v0[2], v0[3]); w.z = cvt_pk_bf16(v1[0], v1[1]); w.w = cvt_pk_bf16(v1[2], v1[3]);
                        *(u32x4*)(rowp + bj * 128) = w; }
                }
            }
    }
};

struct Args { const float* in[21]; float* out; unsigned char* ws; int ph_lo, ph_hi; };
struct Ctx {
    int tid, lane, wave, vcu, G;
    LAS unsigned char* lds;
    unsigned char* ws;
};
constexpr int N_PHASES = 9;

template <bool GU>
__device__ __forceinline__ void transpose_item(const float* W, int K, int N, bf16_t* WT, const float* g, LAS float* scr, int item, int lane) {
    const int nblk = N / 64, kb = item / nblk, nb = item - kb * nblk, k0 = 64 * kb, n0 = 64 * nb;
    f32x4 v[16];
#pragma unroll
    for (int r = 0; r < 16; ++r) { const int k = 4 * r + (lane >> 4); v[r] = *(const f32x4*)(W + (size_t)(k0 + k) * N + n0 + 4 * (lane & 15)); }
#pragma unroll
    for (int r = 0; r < 16; ++r) { const int k = 4 * r + (lane >> 4); const float s = g ? g[k0 + k] : 1.0f; LAS float* p = scr + k * 65 + 4 * (lane & 15);
        p[0] = v[r][0] * s; p[1] = v[r][1] * s; p[2] = v[r][2] * s; p[3] = v[r][3] * s; }
    LDS_WAIT(); asm volatile("" ::: "memory");
    const int c = lane & 7;
#pragma unroll
    for (int j = 0; j < 8; ++j) { const int n = (lane >> 3) + 8 * j; const LAS float* s = scr + (8 * c) * 65 + n;
        u32x4 o; o.x = cvt_pk_bf16(s[0 * 65], s[1 * 65]); o.y = cvt_pk_bf16(s[2 * 65], s[3 * 65]); o.z = cvt_pk_bf16(s[4 * 65], s[5 * 65]); o.w = cvt_pk_bf16(s[6 * 65], s[7 * 65]);
        int nn = n0 + n;
        if (GU) { nn = (nn < 1024) ? ((nn >> 7) * 256 + (nn & 127)) : (((nn - 1024) >> 7) * 256 + 128 + (nn & 127)); }
        *(u32x4*)(WT + (size_t)nn * K + k0 + 8 * c) = o; }
    LDS_WAIT(); asm volatile("" ::: "memory");
}
__device__ __forceinline__ void p0_prologue(const Ctx& C, const Args& A) {
    LAS float* scr = (LAS float*)(C.lds + C.wave * 16640);
    const int gw = C.vcu * NWAVES + C.wave, NGW = C.G * NWAVES, lane = C.lane;
    unsigned char* ws = C.ws;
    { const float* x = A.in[0]; bf16_t* XB = (bf16_t*)(ws + WS_XB); float* r0 = (float*)(ws + WS_R0);
      for (int m = gw; m < MTOK; m += NGW) { const f32x4* xr = (const f32x4*)(x + (size_t)m * DM) + lane; f32x4 v[4]; float s = 0.f;
#pragma unroll
          for (int j = 0; j < 4; ++j) { v[j] = xr[64 * j]; s += (v[j][0] * v[j][0] + v[j][1] * v[j][1]) + (v[j][2] * v[j][2] + v[j][3] * v[j][3]); }
          s = wave_sum(s); if (lane == 0) r0[m] = 1.0f / sqrtf(s * (1.0f / DM) + EPS);
          u32x2* o8 = (u32x2*)(XB + (size_t)m * DM) + lane;
#pragma unroll
          for (int j = 0; j < 4; ++j) { u32x2 w; w.x = cvt_pk_bf16(v[j][0], v[j][1]); w.y = cvt_pk_bf16(v[j][2], v[j][3]); o8[64 * j] = w; } } }
    constexpr int I_IN = 16 * (NIN / 64), I_SQ = 16 * 16, I_GU = NEXP * 16 * 32, I_DN = NEXP * 16 * 16;
    constexpr int NITEMS = I_IN + 3 * I_SQ + I_GU + I_DN;
    for (int it = gw; it < NITEMS; it += NGW) {
        int r = it;
        if (r < I_GU) { const int e = r / (16 * 32); transpose_item<true>(A.in[16] + (size_t)e * 1024 * 2048, 1024, 2048, (bf16_t*)(ws + WS_WGU) + (size_t)e * 2048 * 1024, A.in[13], scr, r - e * 16 * 32, lane); continue; } r -= I_GU;
        if (r < I_DN) { const int e = r / (16 * 16); transpose_item<false>(A.in[18] + (size_t)e * 1024 * 1024, 1024, 1024, (bf16_t*)(ws + WS_WD) + (size_t)e * 1024 * 1024, nullptr, scr, r - e * 16 * 16, lane); continue; } r -= I_DN;
        if (r < I_IN) { transpose_item<false>(A.in[2], 1024, NIN, (bf16_t*)(ws + WS_WIN), A.in[1], scr, r, lane); continue; } r -= I_IN;
        if (r < I_SQ) { transpose_item<false>(A.in[10], 1024, 1024, (bf16_t*)(ws + WS_WR), nullptr, scr, r, lane); continue; } r -= I_SQ;
        if (r < I_SQ) { transpose_item<false>(A.in[11], 1024, 1024, (bf16_t*)(ws + WS_WA), nullptr, scr, r, lane); continue; } r -= I_SQ;
        transpose_item<false>(A.in[12], 1024, 1024, (bf16_t*)(ws + WS_WO), nullptr, scr, r, lane);
    }
    { float* cosT = (float*)(ws + WS_COS); float* sinT = (float*)(ws + WS_SIN); float* sp = (float*)(ws + WS_SP);
      const int gt = C.vcu * 512 + C.tid, NT = C.G * 512;
      for (int i = gt; i < SEQ * 16; i += NT) { const int pos = i >> 4, f = i & 15; const float inv = powf(500000.0f, -(float)f * 0.0625f); const float ang = (float)pos * inv; float s, c; sincosf(ang, &s, &c); cosT[i] = c; sinT[i] = s; }
      for (int i = gt; i < 1024; i += NT) { const float a = A.in[9][i]; sp[i] = log1pf(expf(-a)); } }
}

__device__ __forceinline__ void kmean_bh(const Ctx& C, int bh) {
    const bf16_t* Kt = (const bf16_t*)(C.ws + WS_Z + 3 * ZSTRIDE); float* km = (float*)(C.ws + WS_KMEAN) + (size_t)bh * 1024;
    const int b = bh >> 3, h = bh & 7, cc = C.tid & 15, rg = C.tid >> 4;
    LAS float* red = (LAS float*)C.lds;
    const bf16_t* kb = Kt + (size_t)(b * SEQ) * 1024 + h * 128 + cc * 8;
    for (int j = 0; j < 7; ++j) { float a[8] = {0.f, 0.f, 0.f, 0.f, 0.f, 0.f, 0.f, 0.f};
#pragma unroll
        for (int rr = 0; rr < 8; ++rr) { const u32x4 w = *(const u32x4*)(kb + (size_t)(256 * j + rg + 32 * rr) * 1024);
            a[0] += bf_lo(w.x); a[1] += bf_hi(w.x); a[2] += bf_lo(w.y); a[3] += bf_hi(w.y); a[4] += bf_lo(w.z); a[5] += bf_hi(w.z); a[6] += bf_lo(w.w); a[7] += bf_hi(w.w); }
        LAS float* p = red + (j * 32 + rg) * 128 + cc * 8;
#pragma unroll
        for (int q = 0; q < 8; ++q) p[q] = a[q]; }
    __syncthreads();
    for (int o = C.tid; o < 7 * 128; o += 512) { const int j = o >> 7, d = o & 127; float s = 0.f;
        for (int r = 0; r < 32; ++r) s += red[(j * 32 + r) * 128 + d];
        km[j * 128 + d] = s * (1.0f / 256.0f); }
    VM_WAIT(); __syncthreads();
}

__device__ __forceinline__ void rnn_item(const Ctx& C, const Args& A, int item) {
    constexpr int T = 128;
    const int b = item >> 4, g = item & 15, tid = C.tid, lane = C.lane, wid = C.wave;
    LAS unsigned char* L = C.lds;
    LAS bf16_t* XR = (LAS bf16_t*)(L);
    LAS bf16_t* GG = (LAS bf16_t*)(L + 16896);
    LAS bf16_t* XC = (LAS bf16_t*)(L + 33280);
    LAS float* AA = (LAS float*)(L + 49664);
    LAS float* UU = (LAS float*)(L + 82432);
    LAS float* SEGA = (LAS float*)(L + 115200);
    LAS float* SEGH = (LAS float*)(L + 117248);
    LAS float* CARRY = (LAS float*)(L + 119296);
    const bf16_t* ZX = (const bf16_t*)(C.ws + WS_Z); const bf16_t* ZG = (const bf16_t*)(C.ws + WS_Z + ZSTRIDE); bf16_t* HG = (bf16_t*)(C.ws + WS_HG);
    const size_t rowbase = (size_t)b * SEQ;
    const int ch0 = g * 64;
    const int c = tid & 63, sg = tid >> 6;
    float cw[4], cb;
#pragma unroll
    for (int k = 0; k < 4; ++k) cw[k] = A.in[3][k * 1024 + ch0 + c];
    cb = A.in[4][ch0 + c];
    const int r16 = lane & 15, q4 = lane >> 4;
    float bxv[4], bav[4], spv[4];
#pragma unroll
    for (int n = 0; n < 4; ++n) { bxv[n] = A.in[6][ch0 + 16 * n + r16]; bav[n] = A.in[8][ch0 + 16 * n + r16]; spv[n] = ((const float*)(C.ws + WS_SP))[ch0 + 16 * n + r16]; }
    bf16x8 Bx[2][4], Ba[2][4];
    { const float* wx = A.in[5] + (size_t)g * 4096; const float* wa = A.in[7] + (size_t)g * 4096;
#pragma unroll
      for (int kk = 0; kk < 2; ++kk)
#pragma unroll
          for (int n = 0; n < 4; ++n) { float fx[8], fa[8];
#pragma unroll
              for (int jj = 0; jj < 8; ++jj) { const int i = 32 * kk + 8 * q4 + jj; fx[jj] = wx[i * 64 + 16 * n + r16]; fa[jj] = wa[i * 64 + 16 * n + r16]; }
              u32x4 wxp = {cvt_pk_bf16(fx[0], fx[1]), cvt_pk_bf16(fx[2], fx[3]), cvt_pk_bf16(fx[4], fx[5]), cvt_pk_bf16(fx[6], fx[7])};
              u32x4 wap = {cvt_pk_bf16(fa[0], fa[1]), cvt_pk_bf16(fa[2], fa[3]), cvt_pk_bf16(fa[4], fa[5]), cvt_pk_bf16(fa[6], fa[7])};
              Bx[kk][n] = *reinterpret_cast<bf16x8*>(&wxp); Ba[kk][n] = *reinterpret_cast<bf16x8*>(&wap); } }
    if (tid < 128) CARRY[tid] = 0.f;
    u32x4 px[2], pg[2], ph = {0u, 0u, 0u, 0u};
#define RNN_LOAD(t0) do { _Pragma("unroll") for (int i = 0; i < 2; ++i) { const int p = tid + 512 * i, row = p >> 3, c8 = p & 7; \
        const size_t go = (rowbase + (t0) + row) * 1024 + ch0 + c8 * 8; px[i] = *(const u32x4*)(ZX + go); pg[i] = *(const u32x4*)(ZG + go); } \
        if (tid < 24) { const int row = tid >> 3, c8 = tid & 7; ph = ((t0) > 0) ? *(const u32x4*)(ZX + (rowbase + (t0) - 3 + row) * 1024 + ch0 + c8 * 8) : (u32x4){0u, 0u, 0u, 0u}; } } while (0)
    RNN_LOAD(0);
    __syncthreads();
    for (int ck = 0; ck < SEQ / T; ++ck) {
        const int t0 = ck * T;
#pragma unroll
        for (int i = 0; i < 2; ++i) { const int p = tid + 512 * i, row = p >> 3, c8 = p & 7; *(LAS u32x4*)(XR + (row + 3) * 64 + c8 * 8) = px[i]; *(LAS u32x4*)(GG + row * 64 + c8 * 8) = pg[i]; }
        if (tid < 24) { const int row = tid >> 3, c8 = tid & 7; *(LAS u32x4*)(XR + row * 64 + c8 * 8) = ph; }
        __syncthreads();
        if (ck + 1 < SEQ / T) RNN_LOAD(t0 + T);
        { float x0 = bf2f(XR[(sg * 16 + 0) * 64 + c]), x1 = bf2f(XR[(sg * 16 + 1) * 64 + c]), x2 = bf2f(XR[(sg * 16 + 2) * 64 + c]);
#pragma unroll
          for (int tt = 0; tt < 16; ++tt) { const int t = sg * 16 + tt; const float x3 = bf2f(XR[(t + 3) * 64 + c]);
              const float y = cb + cw[0] * x0 + cw[1] * x1 + cw[2] * x2 + cw[3] * x3;
              XC[t * 64 + c] = (bf16_t)(cvt_pk_bf16(y, 0.f) & 0xffffu); x0 = x1; x1 = x2; x2 = x3; } }
        __syncthreads();
        { bf16x8 Af[2];
#pragma unroll
          for (int kk = 0; kk < 2; ++kk) Af[kk] = *(const LAS bf16x8*)(XC + (16 * wid + r16) * 64 + 32 * kk + 8 * q4);
#pragma unroll
          for (int n = 0; n < 4; ++n) { f32x4 ax = {0.f, 0.f, 0.f, 0.f}, aa = {0.f, 0.f, 0.f, 0.f};
#pragma unroll
              for (int kk = 0; kk < 2; ++kk) { ax = __builtin_amdgcn_mfma_f32_16x16x32_bf16(Af[kk], Bx[kk][n], ax, 0, 0, 0); aa = __builtin_amdgcn_mfma_f32_16x16x32_bf16(Af[kk], Ba[kk][n], aa, 0, 0, 0); }
#pragma unroll
              for (int rg = 0; rg < 4; ++rg) { const int t = 16 * wid + 4 * q4 + rg, j = 16 * n + r16;
                  const float gx = fast_sigmoid(ax[rg] + bxv[n]), ga = fast_sigmoid(aa[rg] + bav[n]);
                  const float la = -8.0f * ga * spv[n]; const float a = __builtin_amdgcn_exp2f(la * 1.4426950408889634f);
                  const float mlt = __builtin_amdgcn_sqrtf(fmaxf(1.0f - a * a, 0.f));
                  const float xc = bf2f(XC[t * 64 + j]);
                  AA[t * 64 + j] = a; UU[t * 64 + j] = mlt * gx * xc; } } }
        __syncthreads();
        float av[16], uv[16];
        { float Ap = 1.f, Hp = 0.f;
#pragma unroll
          for (int tt = 0; tt < 16; ++tt) { const int t = sg * 16 + tt; av[tt] = AA[t * 64 + c]; uv[tt] = UU[t * 64 + c]; Hp = av[tt] * Hp + uv[tt]; Ap *= av[tt]; }
          SEGA[sg * 64 + c] = Ap; SEGH[sg * 64 + c] = Hp; }
        __syncthreads();
        { float h = CARRY[(ck & 1) * 64 + c];
          for (int s2 = 0; s2 < sg; ++s2) h = SEGA[s2 * 64 + c] * h + SEGH[s2 * 64 + c];
#pragma unroll
          for (int tt = 0; tt < 16; ++tt) { const int t = sg * 16 + tt; h = av[tt] * h + uv[tt]; const float o = h * bf2f(GG[t * 64 + c]); XC[t * 64 + c] = (bf16_t)(cvt_pk_bf16(o, 0.f) & 0xffffu); }
          if (sg == 7) CARRY[((ck + 1) & 1) * 64 + c] = h; }
        __syncthreads();
#pragma unroll
        for (int i = 0; i < 2; ++i) { const int p = tid + 512 * i, row = p >> 3, c8 = p & 7; *(u32x4*)(HG + (rowbase + t0 + row) * 1024 + ch0 + c8 * 8) = *(const LAS u32x4*)(XC + row * 64 + c8 * 8); }
    }
    __syncthreads();
#undef RNN_LOAD
}

__device__ __forceinline__ att::BlockRef att_ref(const Ctx& C, int L, int pass) {
    const int bh = L >> 2, x = L & 3, nb = pass ? 7 - x : x, b = bh >> 3, h = bh & 7;
    att::BlockRef r;
    const size_t seq0 = (size_t)(b * SEQ) * 1024 + h * 128;
    r.Q = (const bf16_t*)(C.ws + WS_Z + 2 * ZSTRIDE) + seq0 + (size_t)(nb * 256) * 1024;
    r.K = (const bf16_t*)(C.ws + WS_Z + 3 * ZSTRIDE) + seq0;
    r.V = (const bf16_t*)(C.ws + WS_Z + 4 * ZSTRIDE) + seq0;
    r.O = (bf16_t*)(C.ws + WS_OA) + seq0 + (size_t)(nb * 256) * 1024;
    r.km = (const float*)(C.ws + WS_KMEAN) + (size_t)bh * 1024; r.nb = nb;
    return r;
}
__device__ __forceinline__ void p2_mixers(const Ctx& C, const Args& A) {
    const int lo = (C.vcu * 512) / C.G, hi = ((C.vcu + 1) * 512) / C.G;
#ifndef NO_KM
    { int prev = -1; for (int L = lo; L < hi; ++L) { const int bh = L >> 2; if (bh != prev) { kmean_bh(C, bh); prev = bh; } } }
#endif
#ifndef NO_RNN
    for (int it = C.vcu; it < 256; it += C.G) rnn_item(C, A, it);
#endif
#ifndef NO_ATT
    if (lo < hi) {
        int L = lo, pass = 0; att::Seam S;
        att::BlockRef cur = att_ref(C, L, 0);
        att::moba_prime(cur, (char*)C.lds, S);
        for (;;) {
            const bool more_pass = pass == 0, more_item = L + 1 < hi, last = !more_pass && !more_item;
            const int Ln = more_pass ? L : (more_item ? L + 1 : L), passn = more_pass ? 1 : 0;
            const att::BlockRef nxt = last ? cur : att_ref(C, Ln, passn);
            att::moba_block(cur, nxt, (char*)C.lds, S);
            if (last) break;
            cur = nxt; L = Ln; pass = passn;
        }
    }
#endif
}

__device__ __forceinline__ void p5_router(const Ctx& C, const Args& A, const float* X1) {
    LAS float* WRL = (LAS float*)C.lds;
    LAS int* hist = (LAS int*)(C.lds + MISC_OFF + 1024);
    LAS int* baseL = hist + 32;
    const int tid = C.tid, lane = C.lane, wid = C.wave;
    const float* rw = A.in[14]; const float* gff = A.in[13]; const float* rb = A.in[15];
    for (int i = tid; i < 1024 * 32 / 4; i += 512) { const f32x4 w = *(const f32x4*)(rw + 4 * i); const float s = gff[(4 * i) >> 5]; *(LAS f32x4*)(WRL + 4 * i) = w * s; }
    if (tid < 32) hist[tid] = 0;
    __syncthreads();
    unsigned* cntg = (unsigned*)(C.ws + WS_CTL) + CW_CNT;
    int* elist = (int*)(C.ws + WS_ELIST); float* gwp = (float*)(C.ws + WS_GW); float* r1p = (float*)(C.ws + WS_R1);
    const int j = lane & 31, h = lane >> 5;
    for (int bi = C.vcu; bi < MTOK / 128; bi += C.G) {
        int eidx[4] = {0, 0, 0, 0}; float gate[4] = {0.f, 0.f, 0.f, 0.f}; int rank[4] = {0, 0, 0, 0};
        const int tok = bi * 128 + wid * 32 + j;
        if (wid < 4) {
            const float* xr = X1 + (size_t)tok * 1024 + 4 * h;
            f32x16 acc = {}; float ss = 0.f;
            f32x4 va[16], vb[16];
#define RT_LOAD(dst, kc0) do { _Pragma("unroll") for (int q = 0; q < 16; ++q) dst[q] = *(const f32x4*)(xr + 8 * ((kc0) + q)); } while (0)
#define RT_COMP(src, kc0) do { _Pragma("unroll") for (int q = 0; q < 16; ++q) { const f32x4 v = src[q]; ss += (v[0] * v[0] + v[1] * v[1]) + (v[2] * v[2] + v[3] * v[3]); \
            const LAS float* wp = WRL + (8 * ((kc0) + q) + 4 * h) * 32 + j; \
            _Pragma("unroll") for (int e = 0; e < 4; ++e) acc = __builtin_amdgcn_mfma_f32_32x32x2f32(wp[e * 32], v[e], acc, 0, 0, 0); } } while (0)
            RT_LOAD(va, 0);
#pragma unroll 1
            for (int kc = 0; kc < 128; kc += 32) {
                RT_LOAD(vb, kc + 16);
                RT_COMP(va, kc);
                if (kc + 32 < 128) RT_LOAD(va, kc + 32);
                RT_COMP(vb, kc + 16);
            }
#undef RT_LOAD
#undef RT_COMP
            ss += __shfl_xor(ss, 32);
            const float r1 = 1.0f / sqrtf(ss * (1.0f / 1024.0f) + EPS);
            if (h == 0) r1p[tok] = r1;
            float lv[16];
#pragma unroll
            for (int r = 0; r < 16; ++r) lv[r] = acc[r] * r1 + rb[(r & 3) + 8 * (r >> 2) + 4 * h];
            float tv[4]; int ti[4];
#pragma unroll
            for (int k = 0; k < 4; ++k) { float best = -3.0e38f; int bi_ = 0;
#pragma unroll
                for (int r = 0; r < 16; ++r) { const bool better = lv[r] > best; best = better ? lv[r] : best; bi_ = better ? r : bi_; }
                tv[k] = best; ti[k] = (bi_ & 3) + 8 * (bi_ >> 2) + 4 * h;
#pragma unroll
                for (int r = 0; r < 16; ++r) lv[r] = (r == bi_) ? -3.0e38f : lv[r]; }
            float cv[8]; int ci[8];
#pragma unroll
            for (int k = 0; k < 4; ++k) { cv[k] = tv[k]; ci[k] = ti[k]; cv[4 + k] = __shfl_xor(tv[k], 32); ci[4 + k] = __shfl_xor(ti[k], 32); }
#pragma unroll
            for (int k = 0; k < 4; ++k) { float best = -3.0e38f; int bidx = 1 << 30, bq = 0;
#pragma unroll
                for (int q = 0; q < 8; ++q) { const bool better = (cv[q] > best) || (cv[q] == best && ci[q] < bidx); best = better ? cv[q] : best; bidx = better ? ci[q] : bidx; bq = better ? q : bq; }
                gate[k] = best; eidx[k] = bidx;
#pragma unroll
                for (int q = 0; q < 8; ++q) cv[q] = (q == bq) ? -3.0e38f : cv[q]; }
            { const float m = gate[0]; float den = 0.f;
#pragma unroll
              for (int k = 0; k < 4; ++k) { gate[k] = __expf(gate[k] - m); den += gate[k]; }
              const float inv = 1.0f / den;
#pragma unroll
              for (int k = 0; k < 4; ++k) gate[k] *= inv; }
            if (h == 0) {
#pragma unroll
                for (int k = 0; k < 4; ++k) rank[k] = __hip_atomic_fetch_add(&hist[eidx[k]], 1, __ATOMIC_RELAXED, __HIP_MEMORY_SCOPE_WORKGROUP);
            }
        }
        __syncthreads();
        if (tid < 32) { const int n = hist[tid]; baseL[tid] = n ? (int)__hip_atomic_fetch_add(cntg + 64 * tid, (unsigned)n, RLX_AGENT) : 0; }
        __syncthreads();
        if (wid < 4 && h == 0) {
#pragma unroll
            for (int k = 0; k < 4; ++k) { const int e = eidx[k], pos = baseL[e] + rank[k]; elist[(size_t)e * MTOK + pos] = tok * 4 + k; gwp[tok * 4 + k] = gate[k]; }
        }
        __syncthreads();
        if (tid < 32) hist[tid] = 0;
        __syncthreads();
    }
}

__device__ __forceinline__ void moe_tables(const Ctx& C, LAS int* tstart, LAS int* ecnt) {
    const unsigned* cntg = (const unsigned*)(C.ws + WS_CTL) + CW_CNT;
    if (C.tid < 64) { const int e = C.tid & 31; const int c = (int)__hip_atomic_load(cntg + 64 * e, RLX_AGENT); const int nt = (c + 255) >> 8;
        int incl = nt;
#pragma unroll
        for (int o = 1; o < 32; o <<= 1) { const int v = __shfl_up(incl, o, 32); if (e >= o) incl += v; }
        if (C.tid < 32) { ecnt[e] = c; tstart[e + 1] = incl; if (e == 0) tstart[0] = 0; } }
    __syncthreads();
}

__device__ __forceinline__ void p8_final(const Ctx& C, const Args& A, float* OUT) {
    const int gw = C.vcu * NWAVES + C.wave, NGW = C.G * NWAVES, lane = C.lane;
    const bf16_t* CON = (const bf16_t*)(C.ws + WS_CONTRIB); const float* gf = A.in[20];
    f32x4 gv[4];
#pragma unroll
    for (int j = 0; j < 4; ++j) gv[j] = *((const f32x4*)gf + lane + 64 * j);
    for (int m = gw; m < MTOK; m += NGW) {
        f32x4* xr = (f32x4*)(OUT + (size_t)m * DM) + lane; f32x4 v[4]; float s = 0.f;
#pragma unroll
        for (int j = 0; j < 4; ++j) v[j] = xr[64 * j];
#pragma unroll
        for (int k = 0; k < 4; ++k) { const u32x2* cr = (const u32x2*)(CON + (size_t)(m * 4 + k) * DM) + lane;
#pragma unroll
            for (int j = 0; j < 4; ++j) { const u32x2 w = cr[64 * j]; v[j][0] += bf_lo(w.x); v[j][1] += bf_hi(w.x); v[j][2] += bf_lo(w.y); v[j][3] += bf_hi(w.y); } }
#pragma unroll
        for (int j = 0; j < 4; ++j) s += (v[j][0] * v[j][0] + v[j][1] * v[j][1]) + (v[j][2] * v[j][2] + v[j][3] * v[j][3]);
        s = wave_sum(s); const float r = 1.0f / sqrtf(s * (1.0f / DM) + EPS);
#pragma unroll
        for (int j = 0; j < 4; ++j) xr[64 * j] = v[j] * r * gv[j];
    }
}

__global__ void __launch_bounds__(NWAVES * 64, 2) mega_fwd(Args args) {
    extern __shared__ __attribute__((aligned(16))) unsigned char lds_raw[];
    Ctx C;
    C.lds = (LAS unsigned char*)lds_raw; C.ws = args.ws;
    C.tid = threadIdx.x; C.lane = C.tid & 63; C.wave = __builtin_amdgcn_readfirstlane(C.tid >> 6);
    C.G = gridDim.x; { const int bx = blockIdx.x; C.vcu = (C.G % 8 == 0) ? (bx % 8) * (C.G / 8) + bx / 8 : bx; }
    volatile LAS unsigned* MISC = (volatile LAS unsigned*)(C.lds + MISC_OFF);
    for (int u = C.tid; u < (LDS_BYTES - MISC_OFF) / 4; u += NWAVES * 64) ((LAS unsigned*)(C.lds + MISC_OFF))[u] = 0u;
    __syncthreads();
    unsigned* ctl = (unsigned*)(args.ws + WS_CTL);
    const int lo = args.ph_lo, hi = args.ph_hi;
    const bool use_bar = (hi - lo) > 1;
    XcdBarrier bar; bar.bar = ctl + CW_BAR; bar.x = 0; bar.st = nullptr;
    if (use_bar) bar = xcd_barrier_post(ctl + CW_BAR, MISC + 8);
#ifndef PH_MASK
#define PH_MASK 0x1ff
#endif
#define IN(k) (((PH_MASK >> (k)) & 1) && lo <= (k) && (k) < hi)
#define SEAM(k) do { if (IN(k) && IN((k) + 1)) xcd_barrier(bar); } while (0)
    unsigned char* ws = args.ws;
    LAS int* tstart = (LAS int*)(C.lds + MISC_OFF + 2048);
    LAS int* ecnt = tstart + 64;

    if (IN(0)) { p0_prologue(C, args); SEAM(0); }

    if (IN(1)) {
        pg8::DenseOrder S{(const char*)(ws + WS_XB), (const char*)(ws + WS_WIN), MTOK / 256, NIN / 256, 1024, C.G, C.vcu};
        EpiIn E{(bf16_t*)(ws + WS_Z), (const float*)(ws + WS_R0), (const float*)(ws + WS_COS), (const float*)(ws + WS_SIN)};
        pg8::gemm_phase<EpiIn, pg8::DenseOrder, false>(C.lds, 1024, S, E);
        SEAM(1);
    }
    if (IN(2)) { p2_mixers(C, args); SEAM(2); }

    if (IN(3)) {
        { pg8::DenseOrder S{(const char*)(ws + WS_HG), (const char*)(ws + WS_WR), MTOK / 256, 4, 1024, C.G, C.vcu};
          EpiProjRnn E{(float*)(ws + WS_TMP), (const bf16_t*)(ws + WS_Z + 5 * ZSTRIDE)};
          pg8::gemm_phase<EpiProjRnn, pg8::DenseOrder, false>(C.lds, 1024, S, E); }
        { pg8::DenseOrder S{(const char*)(ws + WS_OA), (const char*)(ws + WS_WA), MTOK / 256, 4, 1024, C.G, C.vcu};
          EpiProjAttn E{(const float*)(ws + WS_TMP), (const bf16_t*)(ws + WS_Z + 6 * ZSTRIDE), (bf16_t*)(ws + WS_MIX)};
          pg8::gemm_phase<EpiProjAttn, pg8::DenseOrder, false>(C.lds, 1024, S, E); }
        SEAM(3);
    }
    if (IN(4)) {
        pg8::DenseOrder S{(const char*)(ws + WS_MIX), (const char*)(ws + WS_WO), MTOK / 256, 4, 1024, C.G, C.vcu};
        EpiOut E{args.in[0], args.out, (bf16_t*)(ws + WS_X1B)};
        pg8::gemm_phase<EpiOut, pg8::DenseOrder, false>(C.lds, 1024, S, E);
        SEAM(4);
    }
    if (IN(5)) { p5_router(C, args, args.out); SEAM(5); }

    if (IN(6)) {
        moe_tables(C, tstart, ecnt);
        pg8::MoeOrder S{tstart, ecnt, (const char*)(ws + WS_X1B), (const char*)(ws + WS_WGU), (size_t)2048 * 1024 * 2, (const int*)(ws + WS_ELIST), 8, 1024, C.G, C.vcu, true};
        EpiGu E{(bf16_t*)(ws + WS_ACT), args.in[17], (const float*)(ws + WS_R1), (const int*)(ws + WS_ELIST)};
        pg8::gemm_phase<EpiGu, pg8::MoeOrder, true>(C.lds, 1024, S, E);
        SEAM(6);
    }
    if (IN(7)) {
        moe_tables(C, tstart, ecnt);
        pg8::MoeOrder S{tstart, ecnt, (const char*)(ws + WS_ACT), (const char*)(ws + WS_WD), (size_t)1024 * 1024 * 2, (const int*)(ws + WS_ELIST), 4, 1024, C.G, C.vcu, false};
        EpiDown E{(bf16_t*)(ws + WS_CONTRIB), args.in[19], (const float*)(ws + WS_GW), (const int*)(ws + WS_ELIST)};
        pg8::gemm_phase<EpiDown, pg8::MoeOrder, false>(C.lds, 1024, S, E);
        SEAM(7);
    }
    if (IN(8)) { p8_final(C, args, args.out); }
#undef IN
#undef SEAM
}

extern "C" void kernel_launch(void* const* d_in, const int* in_sizes, int n_in, void* d_out, int out_size, void* d_ws, size_t ws_size, hipStream_t stream) {
    static int grid = 0;
    if (grid == 0) {
        if (n_in != 21 || out_size != MTOK * DM || ws_size < WS_END) { fprintf(stderr, "kernel_launch: unexpected shapes (n_in %d out %d ws %zu)\n", n_in, out_size, ws_size); grid = -1; return; }
        int dev = 0, cus = 0, per_cu = 0;
        if (hipGetDevice(&dev) != hipSuccess || hipDeviceGetAttribute(&cus, hipDeviceAttributeMultiprocessorCount, dev) != hipSuccess) { grid = -1; return; }
        if (hipFuncSetAttribute((const void*)mega_fwd, hipFuncAttributeMaxDynamicSharedMemorySize, LDS_BYTES) != hipSuccess) { fprintf(stderr, "kernel_launch: hipFuncSetAttribute failed\n"); grid = -1; return; }
        if (hipOccupancyMaxActiveBlocksPerMultiprocessor(&per_cu, (const void*)mega_fwd, NWAVES * 64, LDS_BYTES) != hipSuccess || per_cu < 1) { fprintf(stderr, "kernel_launch: occupancy query says %d\n", per_cu); }
        (void)hipGetLastError();
        grid = cus;
    }
    if (grid < 0) return;
    (void)hipMemsetAsync((char*)d_ws + WS_CTL, 0, CTL_ZERO_BYTES, stream);
    Args a{};
    for (int i = 0; i < 21; ++i) a.in[i] = (const float*)d_in[i];
    a.out = (float*)d_out; a.ws = (unsigned char*)d_ws;
#if MK_N_LAUNCHES == 1
    a.ph_lo = 0; a.ph_hi = N_PHASES;
    hipLaunchKernelGGL(mega_fwd, dim3(grid), dim3(NWAVES * 64), LDS_BYTES, stream, a);
#else
    for (int p = 0; p < N_PHASES; ++p) { a.ph_lo = p; a.ph_hi = p + 1; hipLaunchKernelGGL(mega_fwd, dim3(grid), dim3(NWAVES * 64), LDS_BYTES, stream, a); }
#endif
}
```

```cpp
#include <hip/hip_runtime.h>
#include <cstdio>
#include <cstdint>

#ifndef PROBE_REP
#define PROBE_REP -1
#endif
#define REP(k) for (int rep_ = 0; rep_ < ((PROBE_REP == (k)) ? 2 : 1); ++rep_)
#ifndef PROBE_EPI2
#define PROBE_EPI2 -1
#endif
#ifndef PROBE_DUP
#define PROBE_DUP -1
#endif
#ifndef PROBE_DUP2
#define PROBE_DUP2 -1
#endif
#ifndef PROBE_STAGGER
#define PROBE_STAGGER -1
#endif
#ifndef MK_N_LAUNCHES
#define MK_N_LAUNCHES 1
#endif

#define LAS __attribute__((address_space(3)))
#define GAS __attribute__((address_space(1)))
typedef unsigned short bf16_t;
typedef short bf16x8 __attribute__((ext_vector_type(8)));
typedef short s16x4 __attribute__((ext_vector_type(4)));
typedef float f32x4 __attribute__((ext_vector_type(4)));
typedef float f32x2 __attribute__((ext_vector_type(2)));
typedef float f32x16 __attribute__((ext_vector_type(16)));
typedef unsigned u32x4 __attribute__((ext_vector_type(4)));
typedef unsigned u32x2 __attribute__((ext_vector_type(2)));
typedef GAS unsigned gu32;
#define RLX_AGENT __ATOMIC_RELAXED, __HIP_MEMORY_SCOPE_AGENT
#define LDS_WAIT() asm volatile("s_waitcnt lgkmcnt(0)" ::: "memory")
#define VM_WAIT() asm volatile("s_waitcnt vmcnt(0)" ::: "memory")

constexpr int DM = 1024, BATCH = 16, SEQ = 2048, MTOK = BATCH * SEQ;
constexpr int NIN = 7168;
constexpr int NHEAD = 8, HD = 128;
constexpr int NEXP = 32, TOPK = 4, DEXP = 1024;
constexpr int NASSIGN = MTOK * TOPK;
constexpr int MAXROWS = NASSIGN + NEXP * 256;
constexpr float EPS = 1e-6f;
constexpr int NWAVES = 8;

constexpr size_t MiB = 1u << 20;
constexpr size_t WS_CTL = 0, CTL_ZERO_BYTES = 1 * MiB;
constexpr size_t WS_R0 = 1 * MiB;
constexpr size_t WS_R1 = WS_R0 + 128 * 1024;
constexpr size_t WS_COS = WS_R1 + 128 * 1024;
constexpr size_t WS_SIN = WS_COS + 128 * 1024;
constexpr size_t WS_SP = WS_SIN + 128 * 1024;
constexpr size_t WS_KMEAN = WS_SP + 64 * 1024;
constexpr size_t WS_GW = 3 * MiB;
constexpr size_t WS_ELIST = 4 * MiB;
constexpr size_t WS_WIN = 16 * MiB;
constexpr size_t WS_WR = 30 * MiB, WS_WA = 32 * MiB, WS_WO = 34 * MiB;
constexpr size_t WS_WGU = 36 * MiB;
constexpr size_t WS_WD = 164 * MiB;
constexpr size_t WS_Z = 228 * MiB;
constexpr size_t ZSTRIDE = 64 * MiB;
constexpr size_t WS_TMP = WS_Z;
constexpr size_t WS_ACT = WS_Z;
constexpr size_t WS_X1B = WS_Z + 272 * MiB;
constexpr size_t WS_G4 = 676 * MiB;
constexpr size_t WS_XB = WS_G4, WS_HG = WS_G4 + 64 * MiB, WS_OA = WS_G4 + 128 * MiB, WS_MIX = WS_G4 + 192 * MiB;
constexpr size_t WS_CONTRIB = WS_G4;
constexpr size_t WS_END = 932 * MiB;
static_assert((size_t)MAXROWS * 2048 <= 272 * MiB, "act");
constexpr int CW_TMO = 0, CW_BAR = 4096, CW_CNT = 8192;

constexpr int RING_BYTES = 131072;
constexpr int MISC_OFF = 139264;
constexpr int LDS_BYTES = 147456;

__device__ __forceinline__ unsigned cvt_pk_bf16(float lo, float hi) { unsigned r; asm volatile("v_cvt_pk_bf16_f32 %0, %1, %2" : "=v"(r) : "v"(lo), "v"(hi)); return r; }
__device__ __forceinline__ float bf_lo(unsigned w) { return __uint_as_float(w << 16); }
__device__ __forceinline__ float bf_hi(unsigned w) { return __uint_as_float(w & 0xffff0000u); }
__device__ __forceinline__ float bf2f(bf16_t b) { return __uint_as_float(((unsigned)b) << 16); }
__device__ __forceinline__ float fast_sigmoid(float x) { return __builtin_amdgcn_rcpf(1.0f + __builtin_amdgcn_exp2f(-1.4426950408889634f * x)); }
__device__ __forceinline__ float wave_sum(float v) {
#pragma unroll
    for (int o = 1; o < 64; o <<= 1) v += __shfl_xor(v, o);
    return v;
}

#define XB_TMO      128
#define XB_XCNT(j)  (256  + 64 * (j))
#define XB_XSUB(j)  (1280 + 64 * (j))
#define XB_XGEN(j)  (2304 + 64 * (j))
#define XB_TOP      3328
#define XB_TOPGEN   3392
#define XCD_BAR_WORDS 3456
#define XB_SPIN_CAP (1u << 18)
__device__ __forceinline__ unsigned xb_ld(unsigned* p)              { return __hip_atomic_load(p, __ATOMIC_RELAXED, __HIP_MEMORY_SCOPE_AGENT); }
__device__ __forceinline__ unsigned xb_add(unsigned* p, unsigned v) { return __hip_atomic_fetch_add(p, v, __ATOMIC_RELAXED, __HIP_MEMORY_SCOPE_AGENT); }
__device__ __forceinline__ unsigned xb_xcc_id() { return (unsigned)__builtin_amdgcn_s_getreg((3 << 11) | 20) & 0xFu; }
#define XB_SPIN(cond, bar) do { unsigned _sp = 0; while (cond) { __builtin_amdgcn_s_sleep(1); \
    if ((++_sp & 255u) == 0u) { if (xb_ld(&(bar)[XB_TMO])) break; if (_sp > XB_SPIN_CAP) { atomicAdd(&(bar)[XB_TMO], 1u); break; } } } } while (0)
struct XcdBarrier { unsigned* bar; unsigned x; volatile LAS unsigned* st; };
__device__ __forceinline__ XcdBarrier xcd_barrier_post(unsigned* bar, volatile LAS unsigned* st) {
    XcdBarrier b; b.bar = bar; b.x = xb_xcc_id(); b.st = st;
    if (threadIdx.x == 0) (void)xb_add(&bar[XB_XCNT(b.x)], 1u);
    return b;
}
__device__ __forceinline__ void xcd_barrier_complete(unsigned* bar, unsigned x, unsigned& nloc, unsigned& nx) {
    const unsigned G = gridDim.x * gridDim.y * gridDim.z;
    unsigned sum, cnt, mine, sp = 0u;
    for (;;) {
        sum = 0u; cnt = 0u; mine = 0u;
#pragma unroll
        for (unsigned j = 0; j < 16; ++j) { const unsigned c = xb_ld(&bar[XB_XCNT(j)]); sum += c; cnt += (c > 0u) ? 1u : 0u; mine = (j == x) ? c : mine; }
        if (sum == G) break;
        __builtin_amdgcn_s_sleep(1);
        if ((++sp & 255u) == 0u) { if (xb_ld(&bar[XB_TMO])) break; if (sp > XB_SPIN_CAP) { atomicAdd(&bar[XB_TMO], 1u); break; } }
    }
    nloc = mine > 0u ? mine : 1u; nx = cnt > 0u ? cnt : 1u;
}
__device__ __forceinline__ void xcd_barrier(const XcdBarrier& b) {
    asm volatile("s_waitcnt vmcnt(0)" ::: "memory");
    __syncthreads();
    if (threadIdx.x == 0) {
        unsigned* bar = b.bar;
        __builtin_amdgcn_s_waitcnt(0);
        unsigned nloc = b.st[0], nx = b.st[1];
        if (nloc == 0u) { xcd_barrier_complete(bar, b.x, nloc, nx); b.st[0] = nloc; b.st[1] = nx; }
        const unsigned old = xb_add(&bar[XB_XSUB(b.x)], 1u);
        const unsigned gen = old / nloc;
        if (old + 1u == (gen + 1u) * nloc) {
            __builtin_amdgcn_fence(__ATOMIC_RELEASE, "agent");
            asm volatile("s_waitcnt vmcnt(0)" ::: "memory");
            const unsigned og = xb_add(&bar[XB_TOP], 1u);
            const unsigned tg = og / nx;
            if (og + 1u == (tg + 1u) * nx) xb_add(&bar[XB_TOPGEN], 1u);
            else XB_SPIN(xb_ld(&bar[XB_TOPGEN]) == tg, bar);
            __builtin_amdgcn_fence(__ATOMIC_ACQUIRE, "agent");
            xb_add(&bar[XB_XGEN(b.x)], 1u);
            asm volatile("s_waitcnt vmcnt(0)" ::: "memory");
        } else {
            XB_SPIN(xb_ld(&bar[XB_XGEN(b.x)]) == gen, bar);
            __builtin_amdgcn_fence(__ATOMIC_ACQUIRE, "agent");
            asm volatile("s_waitcnt vmcnt(0)" ::: "memory");
        }
    }
    __syncthreads();
}

namespace pg8 {
constexpr int BM = 256, BK = 64, HALF = 128, HTB = HALF * BK * 2, STAGE_BYTES = 8 * HTB;
__host__ __device__ __forceinline__ int lds_byte(int r, int c) { const int st = (r >> 4) * 2 + (c >> 5), rr = r & 15, cc = c & 31, ob = rr * 64 + cc * 2; return st * 1024 + (ob ^ (((ob >> 9) & 1) << 5)); }
__host__ __device__ __forceinline__ void stage_rc(int b, int& R, int& C) { const int st = b / 1024, sb = b % 1024, swz = sb ^ (((sb >> 9) & 1) << 5); R = (st >> 1) * 16 + swz / 64; C = (st & 1) * 32 + (swz % 64) / 2; }
__host__ __device__ __forceinline__ int perm32(int rho) { const int n = rho >> 4, i = rho & 15; return 8 * (i >> 2) + 4 * n + (i & 3); }

struct Unit { int pm, pn; const char* a; const char* b; int e, rbase, cnt, skip; };

template <class Epi, class Sched, bool GATHER, bool ALIGN_EPI = true, bool SP2 = true>
__device__ __forceinline__ void gemm_phase(LAS unsigned char* lds, const int K, const Sched& S, const Epi& E) {
    const int tid = threadIdx.x, wid = __builtin_amdgcn_readfirstlane(tid >> 6), lane = tid & 63, wr = wid >> 2, wc = wid & 3, fr = lane & 15, fq = lane >> 4;
    const int nt = K / BK;
    unsigned voffA[2], voffB[2]; int RA[2], CA[2];
#pragma unroll
    for (int i = 0; i < 2; ++i) { int R, C; stage_rc(tid * 16 + i * 8192, R, C); const int Rb = Epi::PERM ? ((R & ~31) + perm32(R & 31)) : R;
        RA[i] = R; CA[i] = C; voffA[i] = (unsigned)(R * K + C) * 2u; voffB[i] = (unsigned)(Rb * K + C) * 2u; }
    const size_t kstep = (size_t)(BK * 2);
    const size_t hstep = (size_t)HALF * K * 2;
    const unsigned ldsw = (unsigned)wid * 1024u;
    const int aoff = lds_byte(wr * 64 + fr, fq * 8), boff = lds_byte(wc * 32 + fr, fq * 8);
#define PG8_SA(b, h) (((b) * 2 + (h)) * HTB)
#define PG8_SB(b, h) ((4 + (b) * 2 + (h)) * HTB)
#define PG8_STAGE(bufoff, gbase, voff) do { _Pragma("unroll") for (int _i = 0; _i < 2; ++_i) \
        __builtin_amdgcn_global_load_lds((const unsigned*)((const char*)(gbase) + (voff)[_i]), (LAS unsigned*)(lds + (bufoff) + ldsw + _i * 8192), 16, 0, 0); } while (0)
#define PG8_STAGE_A(bufoff, base, h, useNext) do { if constexpr (GATHER) { \
        unsigned _v[2]; _v[0] = (useNext) ? gn[h][0] : gc[h][0]; _v[1] = (useNext) ? gn[h][1] : gc[h][1]; PG8_STAGE(bufoff, base, _v); } \
        else { PG8_STAGE(bufoff, (base) + (h) * hstep, voffA); } } while (0)
#define PG8_LDA(dst, b, h) do { _Pragma("unroll") for (int m = 0; m < 4; ++m) _Pragma("unroll") for (int k = 0; k < 2; ++k) dst[m][k] = *(const LAS bf16x8*)(lds + PG8_SA(b, h) + aoff + m * 2048 + k * 1024); } while (0)
#define PG8_LDB(dst, b, h) do { _Pragma("unroll") for (int n = 0; n < 2; ++n) _Pragma("unroll") for (int k = 0; k < 2; ++k) dst[n][k] = *(const LAS bf16x8*)(lds + PG8_SB(b, h) + boff + n * 2048 + k * 1024); } while (0)
#define PG8_MMA(ai, bj, At, Bt) do { __builtin_amdgcn_s_setprio(1); _Pragma("unroll") for (int m = 0; m < 4; ++m) _Pragma("unroll") for (int n = 0; n < 2; ++n) _Pragma("unroll") for (int k = 0; k < 2; ++k) \
        acc[ai][bj][m][n] = __builtin_amdgcn_mfma_f32_16x16x32_bf16(Bt[n][k], At[m][k], acc[ai][bj][m][n], 0, 0, 0); __builtin_amdgcn_s_setprio(0); } while (0)
#define PG8_WAIT_V(n) asm volatile("s_waitcnt vmcnt(" #n ")" ::: "memory")
#define PG8_WAIT_L(n) asm volatile("s_waitcnt lgkmcnt(" #n ")" ::: "memory")
#define PG8_BAR __builtin_amdgcn_s_barrier()
#define PG8_SCHED __builtin_amdgcn_sched_barrier(0)
    Unit cur, nxt; int ui = 0;
    if (!S.next(0, cur)) return;
    f32x4 acc[2][2][4][2];
#pragma unroll
    for (int a = 0; a < 2; ++a)
#pragma unroll
        for (int b = 0; b < 2; ++b)
#pragma unroll
            for (int m = 0; m < 4; ++m)
#pragma unroll
                for (int n = 0; n < 2; ++n) acc[a][b][m][n] = (f32x4){0.f, 0.f, 0.f, 0.f};
    bf16x8 At[4][2], B0[2][2], B1[2][2];
    unsigned gc[2][2] = {{0u, 0u}, {0u, 0u}}, gn[2][2] = {{0u, 0u}, {0u, 0u}};
    if constexpr (GATHER) { S.rows(cur, RA, CA, gc); gn[0][0] = gc[0][0]; gn[0][1] = gc[0][1]; gn[1][0] = gc[1][0]; gn[1][1] = gc[1][1]; }
    const char* cA = cur.a; const char* cB = cur.b;
    if constexpr (SP2) {
        PG8_STAGE(PG8_SB(0, 0), cB, voffB); PG8_STAGE(PG8_SB(0, 1), cB + hstep, voffB); PG8_STAGE_A(PG8_SA(0, 0), cA, 0, false); PG8_STAGE_A(PG8_SA(0, 1), cA, 1, false);
        if (wr == 1) PG8_BAR;
        PG8_WAIT_V(2); PG8_BAR;
        PG8_STAGE(PG8_SB(1, 0), cB + kstep, voffB); PG8_STAGE_A(PG8_SA(1, 0), cA + kstep, 0, false); PG8_STAGE(PG8_SB(1, 1), cB + hstep + kstep, voffB);
        PG8_WAIT_V(6); PG8_BAR;
    } else {
    PG8_STAGE(PG8_SB(0, 0), cB, voffB); PG8_STAGE_A(PG8_SA(0, 0), cA, 0, false); PG8_STAGE(PG8_SB(0, 1), cB + hstep, voffB); PG8_STAGE_A(PG8_SA(0, 1), cA, 1, false);
    if (wr == 1) PG8_BAR;
    PG8_WAIT_V(4); PG8_BAR;
    PG8_STAGE(PG8_SB(1, 0), cB + kstep, voffB); PG8_STAGE_A(PG8_SA(1, 0), cA + kstep, 0, false); PG8_STAGE(PG8_SB(1, 1), cB + hstep + kstep, voffB);
    PG8_WAIT_V(6); PG8_BAR;
    }
    for (;;) {
        const bool has_next = S.next(ui + 1, nxt);
        const char* nA = has_next ? nxt.a : cA; const char* nB = has_next ? nxt.b : cB;
        for (int t = 0; t < nt; t += 2) {
            const bool last = (t == nt - 2);
            const char* a1 = cA + (size_t)(t + 1) * kstep;
            const char* a2 = last ? nA : cA + (size_t)(t + 2) * kstep; const char* b2 = last ? nB : cB + (size_t)(t + 2) * kstep;
            const char* a3 = a2 + kstep; const char* b3 = b2 + kstep;
            if constexpr (GATHER) { if (last && has_next) S.rows(nxt, RA, CA, gn); }
            if constexpr (SP2) {
            PG8_LDB(B0, 0, 0); PG8_LDB(B1, 0, 1); PG8_SCHED; PG8_LDA(At, 0, 0); PG8_STAGE_A(PG8_SA(1, 1), a1, 1, false);
            PG8_WAIT_V(8); PG8_WAIT_L(0); PG8_BAR; PG8_MMA(0, 0, At, B0); PG8_MMA(0, 1, At, B1); PG8_BAR; PG8_SCHED;
            PG8_LDA(At, 0, 1); PG8_STAGE(PG8_SB(0, 0), b2, voffB); PG8_STAGE(PG8_SB(0, 1), b2 + hstep, voffB); PG8_STAGE_A(PG8_SA(0, 0), a2, 0, last);
            PG8_WAIT_V(8); PG8_WAIT_L(0); PG8_BAR; PG8_MMA(1, 0, At, B0); PG8_MMA(1, 1, At, B1); PG8_BAR; PG8_SCHED;
            PG8_LDB(B0, 1, 0); PG8_LDB(B1, 1, 1); PG8_SCHED; PG8_LDA(At, 1, 0); PG8_STAGE_A(PG8_SA(0, 1), a2, 1, last);
            PG8_WAIT_V(8); PG8_WAIT_L(0); PG8_BAR; PG8_MMA(0, 0, At, B0); PG8_MMA(0, 1, At, B1); PG8_BAR; PG8_SCHED;
            PG8_LDA(At, 1, 1); PG8_STAGE(PG8_SB(1, 0), b3, voffB); PG8_STAGE(PG8_SB(1, 1), b3 + hstep, voffB); PG8_STAGE_A(PG8_SA(1, 0), a3, 0, last);
            PG8_WAIT_V(8); PG8_WAIT_L(0); PG8_BAR; PG8_MMA(1, 0, At, B0); PG8_MMA(1, 1, At, B1); PG8_BAR; PG8_SCHED;
            } else {
            PG8_LDB(B0, 0, 0); PG8_SCHED; PG8_LDA(At, 0, 0); PG8_STAGE_A(PG8_SA(1, 1), a1, 1, false);
            PG8_WAIT_L(8); PG8_BAR; PG8_WAIT_L(0); PG8_MMA(0, 0, At, B0); PG8_BAR; PG8_SCHED;
            PG8_LDB(B1, 0, 1); PG8_STAGE(PG8_SB(0, 0), b2, voffB);
            PG8_BAR; PG8_WAIT_L(0); PG8_MMA(0, 1, At, B1); PG8_BAR;
            PG8_LDA(At, 0, 1); PG8_STAGE_A(PG8_SA(0, 0), a2, 0, last);
            PG8_BAR; PG8_WAIT_L(0); PG8_MMA(1, 0, At, B0); PG8_BAR; PG8_SCHED;
            PG8_STAGE(PG8_SB(0, 1), b2 + hstep, voffB);
            PG8_WAIT_V(6); PG8_BAR; PG8_MMA(1, 1, At, B1); PG8_BAR;
            PG8_LDB(B0, 1, 0); PG8_SCHED; PG8_LDA(At, 1, 0); PG8_STAGE_A(PG8_SA(0, 1), a2, 1, last);
            PG8_WAIT_L(8); PG8_BAR; PG8_WAIT_L(0); PG8_MMA(0, 0, At, B0); PG8_BAR; PG8_SCHED;
            PG8_LDB(B1, 1, 1); PG8_STAGE(PG8_SB(1, 0), b3, voffB);
            PG8_BAR; PG8_WAIT_L(0); PG8_MMA(0, 1, At, B1); PG8_BAR;
            PG8_LDA(At, 1, 1); PG8_STAGE_A(PG8_SA(1, 0), a3, 0, last);
            PG8_BAR; PG8_WAIT_L(0); PG8_MMA(1, 0, At, B0); PG8_BAR; PG8_SCHED;
            PG8_STAGE(PG8_SB(1, 1), b3 + hstep, voffB);
            PG8_WAIT_V(6); PG8_BAR; PG8_MMA(1, 1, At, B1); PG8_BAR;
            }
        }
        if constexpr (ALIGN_EPI) { if (wr == 0) PG8_BAR; }
        if (PROBE_DUP2 == Epi::PID && cur.skip) {
#pragma unroll
            for (int a = 0; a < 2; ++a)
#pragma unroll
                for (int b = 0; b < 2; ++b)
#pragma unroll
                    for (int m = 0; m < 4; ++m)
#pragma unroll
                        for (int n = 0; n < 2; ++n) acc[a][b][m][n] *= 0.0f;
        } else
        E(acc, cur, wr, wc, fr, fq);
        if constexpr (PROBE_EPI2 == Epi::PID) { asm volatile("" ::: "memory"); E(acc, cur, wr, wc, fr, fq); }
        if (!has_next) break;
        if (!(PROBE_DUP2 == Epi::PID && cur.skip)) {
#pragma unroll
        for (int a = 0; a < 2; ++a)
#pragma unroll
            for (int b = 0; b < 2; ++b)
#pragma unroll
                for (int m = 0; m < 4; ++m)
#pragma unroll
                    for (int n = 0; n < 2; ++n) acc[a][b][m][n] = (f32x4){0.f, 0.f, 0.f, 0.f};
        }
        cur = nxt; cA = nA; cB = nB; ++ui;
        if constexpr (ALIGN_EPI) { if (wr == 1) PG8_BAR; }
        if constexpr (GATHER) { gc[0][0] = gn[0][0]; gc[0][1] = gn[0][1]; gc[1][0] = gn[1][0]; gc[1][1] = gn[1][1]; }
    }
    PG8_WAIT_V(0);
    if constexpr (!ALIGN_EPI) { if (wr == 0) PG8_BAR; }
    PG8_BAR;
#undef PG8_SA
#undef PG8_SB
#undef PG8_STAGE
#undef PG8_STAGE_A
#undef PG8_LDA
#undef PG8_LDB
#undef PG8_MMA
#undef PG8_WAIT_V
#undef PG8_WAIT_L
#undef PG8_BAR
#undef PG8_SCHED
}

struct DenseOrder {
    const char* A; const char* Bt; int nM, nN, K, G, vcu; int dup;
    __device__ __forceinline__ bool next(int i, Unit& u) const {
        int pm, pn; u.skip = (dup == 2) ? ((i & 1) == 0) : 0; if (dup) i >>= 1;
        if (G == 256 && (nM % 64) == 0 && (nN % 4) == 0) {
            const int x = vcu >> 5, w = vcu & 31, ncg = nN >> 2, rg = i / ncg, cg = i - rg * ncg, rpx = nM >> 3;
            if (rg * 8 >= rpx) return false;
            pm = x * rpx + rg * 8 + (w & 7); pn = cg * 4 + (w >> 3);
        } else { const int L = i * G + vcu; if (L >= nM * nN) return false; pm = L / nN; pn = L - pm * nN; }
        u.pm = pm; u.pn = pn; u.a = A + (size_t)pm * 256 * K * 2; u.b = Bt + (size_t)pn * 256 * K * 2; u.e = 0; u.rbase = 0; u.cnt = 0;
        return true;
    }
};
struct MoeOrder {
    const LAS int* tstart;
    const LAS int* ecnt;
    const char* A; const char* Bt; size_t bstride; const int* elist; int nN, K, G, vcu; bool gatherA;
    __device__ __forceinline__ bool next(int i, Unit& u) const {
        const int L = i * G + vcu, gt = L / nN, pn = L - gt * nN;
        const int total = tstart[32];
        if (gt >= total) { LDS_WAIT(); return false; }
        int e = 0;
#pragma unroll 1
        for (int k = 1; k < 32; ++k) e += (tstart[k] <= gt) ? 1 : 0;
        const int rb = (gt - tstart[e]) * 256, c = ecnt[e];
        LDS_WAIT();
        u.skip = 0; u.pm = gt; u.pn = pn; u.e = __builtin_amdgcn_readfirstlane(e); u.rbase = __builtin_amdgcn_readfirstlane(rb); u.cnt = __builtin_amdgcn_readfirstlane(c);
        u.a = gatherA ? A : A + (size_t)gt * 256 * K * 2;
        u.b = Bt + (size_t)u.e * bstride + (size_t)pn * 256 * K * 2;
        return true;
    }
    __device__ __forceinline__ void rows(const Unit& u, const int (&RA)[2], const int (&CA)[2], unsigned (&g)[2][2]) const {
#pragma unroll
        for (int h = 0; h < 2; ++h)
#pragma unroll
            for (int i = 0; i < 2; ++i) { int r = u.rbase + RA[i] + 128 * h; r = r < u.cnt ? r : u.cnt - 1;
                const int id = elist[(size_t)u.e * MTOK + r]; g[h][i] = (unsigned)(id >> 2) * (unsigned)(K * 2) + (unsigned)(CA[i] * 2); }
    }
};
}

namespace att {
constexpr int D = 128, LDP = 1024;
constexpr float SCALE = 0.08838834764831845f;
constexpr float THR = 8.f;
constexpr int NW = 8, QBLK = 32, KVBLK = 64, QB = NW * QBLK;
constexpr int SHM_V = KVBLK * D * 2, SHM_K = KVBLK * D * 2;
constexpr int LDS_BYTES = 2 * SHM_V + 2 * SHM_K + NW * 64 * 4;
#define KSWZ(row, colB) ((row) * 256 + ((colB) ^ (((row) & 7) << 4)))
#define SBAR() __builtin_amdgcn_sched_barrier(0)
__device__ __forceinline__ int v_st(int k, int c) { const int kk = (k & ~0xC) | ((k & 4) << 1) | ((k & 8) >> 1); return ((kk >> 3) * 4 + (c >> 5)) * 512 + ((kk & 7) * 32 + (c & 31)) * 2; }
__device__ __forceinline__ int v_rd_base(int lane) { return ((lane & 3) << 3) | (((lane >> 2) & 3) << 6) | (((lane >> 4) & 1) << 5) | (((lane >> 5) & 1) << 8); }
constexpr int v_rd_off(int d0, int ks, int half) { return d0 * 512 + ks * 4096 + half * 2048; }
__device__ __forceinline__ int crow(int r, int hi) { return (r & 3) + 8 * (r >> 2) + 4 * hi; }
__device__ __forceinline__ unsigned cvtpk(float lo, float hi) { unsigned r; asm volatile("v_cvt_pk_bf16_f32 %0, %1, %2" : "=v"(r) : "v"(lo), "v"(hi)); return r; }
__device__ __forceinline__ bf16x8 load8(const bf16_t* p) { return *reinterpret_cast<const bf16x8*>(p); }
__device__ __forceinline__ void mask_tile(f32x16& p0, f32x16& p1, int dq) {
    const float NEG = -__builtin_inff();
#pragma unroll
    for (int r = 0; r < 16; ++r) {
        const int c = (r & 3) + 8 * (r >> 2);
        if (dq - c < 0) p0[r] = NEG;
        if (dq - c - 32 < 0) p1[r] = NEG;
    }
}
__device__ __forceinline__ void mask_all(f32x16& p0, f32x16& p1, bool drop) {
    const float NEG = -__builtin_inff();
#pragma unroll
    for (int r = 0; r < 16; ++r) { p0[r] = drop ? NEG : p0[r]; p1[r] = drop ? NEG : p1[r]; }
}
__device__ __forceinline__ void partialSM(f32x16& p0, f32x16& p1, float& m_reg, float& mn, float& alpha) {
    float pmax = p0[0]; for (int r = 1; r < 16; ++r) pmax = fmaxf(pmax, p0[r]); for (int r = 0; r < 16; ++r) pmax = fmaxf(pmax, p1[r]);
    { auto rr = __builtin_amdgcn_permlane32_swap(__float_as_uint(pmax), __float_as_uint(pmax), false, false);
      pmax = fmaxf(__uint_as_float(rr[0]), __uint_as_float(rr[1])); }
    constexpr float C2 = 1.4426950408889634f * SCALE;
    if (__builtin_expect(__all((pmax - m_reg) * SCALE <= THR), 1)) { mn = m_reg; alpha = 1.f; }
    else { mn = fmaxf(m_reg, pmax); alpha = __builtin_amdgcn_exp2f((m_reg - mn) * C2); m_reg = mn; }
    const float mnL = -mn * C2;
    for (int r = 0; r < 16; ++r) p0[r] = fmaf(p0[r], C2, mnL); for (int r = 0; r < 16; ++r) p1[r] = fmaf(p1[r], C2, mnL);
    for (int r = 0; r < 16; ++r) p0[r] = __builtin_amdgcn_exp2f(p0[r]);
}
__device__ __forceinline__ void finishSM(f32x16& p0, f32x16& p1, float alpha, float& l_reg, bf16x8& pa0, bf16x8& pa1, bf16x8& pa2, bf16x8& pa3) {
    for (int r = 0; r < 16; ++r) p1[r] = __builtin_amdgcn_exp2f(p1[r]);
    float ps = 0; for (int r = 0; r < 16; ++r) ps += p0[r]; for (int r = 0; r < 16; ++r) ps += p1[r];
    { auto rr = __builtin_amdgcn_permlane32_swap(__float_as_uint(ps), __float_as_uint(ps), false, false);
      ps = __uint_as_float(rr[0]) + __uint_as_float(rr[1]); }
    l_reg = l_reg * alpha + ps;
#define PK4(P, B_, OUT) do { unsigned a0 = cvtpk(P[B_+0], P[B_+1]), a1 = cvtpk(P[B_+2], P[B_+3]);                          \
        unsigned b0 = cvtpk(P[B_+4], P[B_+5]), b1 = cvtpk(P[B_+6], P[B_+7]);                                             \
        auto r0 = __builtin_amdgcn_permlane32_swap(a0, b0, false, false); auto r1 = __builtin_amdgcn_permlane32_swap(a1, b1, false, false); \
        u32x4 w = {r0[0], r1[0], r0[1], r1[1]}; OUT = *reinterpret_cast<bf16x8*>(&w); } while (0)
    PK4(p0, 0, pa0); PK4(p0, 8, pa1); PK4(p1, 0, pa2); PK4(p1, 8, pa3);
#undef PK4
}
template <int KB>
__device__ __forceinline__ void qkt(f32x16& p0, f32x16& p1, const char* K_lds, int r32, int hi, const bf16x8* qr) {
    p0 = f32x16{}; p1 = f32x16{};
    const char* kb[4];
#pragma unroll
    for (int dd = 0; dd < 4; ++dd) kb[dd] = K_lds + KB * SHM_K + KSWZ(r32, (dd * 16 + hi * 8) * 2);
#pragma unroll
    for (int d0 = 0; d0 < 8; ++d0) { const char* a = kb[d0 & 3] + (d0 >> 2) * 128;
        bf16x8 b0 = *reinterpret_cast<const bf16x8*>(a);
        bf16x8 b1 = *reinterpret_cast<const bf16x8*>(a + 32 * 256);
        p0 = __builtin_amdgcn_mfma_f32_32x32x16_bf16(b0, qr[d0], p0, 0, 0, 0);
        p1 = __builtin_amdgcn_mfma_f32_32x32x16_bf16(b1, qr[d0], p1, 0, 0, 0); }
}
template <int VB>
__device__ __forceinline__ void pv_tile(f32x16* o, int vb0, bf16x8 pa0, bf16x8 pa1, bf16x8 pa2, bf16x8 pa3) {
#define TRRD(dst, off) asm volatile("ds_read_b64_tr_b16 %0, %1 offset:%2" : "=&v"(dst) : "v"(vb0), "i"(off) : "memory")
#define PV_D0(d0) do { s16x4 l0, l1, l2, l3, h0, h1, h2, h3; constexpr int b_ = VB * SHM_V + v_rd_off(d0, 0, 0); \
        TRRD(l0, b_); TRRD(h0, b_ + 2048); TRRD(l1, b_ + 4096); TRRD(h1, b_ + 6144); TRRD(l2, b_ + 8192); TRRD(h2, b_ + 10240); TRRD(l3, b_ + 12288); TRRD(h3, b_ + 14336); \
        asm volatile("s_waitcnt lgkmcnt(0)" ::: "memory"); SBAR();   \
        o[d0] = __builtin_amdgcn_mfma_f32_32x32x16_bf16(pa0, (bf16x8){l0[0], l0[1], l0[2], l0[3], h0[0], h0[1], h0[2], h0[3]}, o[d0], 0, 0, 0);   \
        o[d0] = __builtin_amdgcn_mfma_f32_32x32x16_bf16(pa1, (bf16x8){l1[0], l1[1], l1[2], l1[3], h1[0], h1[1], h1[2], h1[3]}, o[d0], 0, 0, 0);   \
        o[d0] = __builtin_amdgcn_mfma_f32_32x32x16_bf16(pa2, (bf16x8){l2[0], l2[1], l2[2], l2[3], h2[0], h2[1], h2[2], h2[3]}, o[d0], 0, 0, 0);   \
        o[d0] = __builtin_amdgcn_mfma_f32_32x32x16_bf16(pa3, (bf16x8){l3[0], l3[1], l3[2], l3[3], h3[0], h3[1], h3[2], h3[3]}, o[d0], 0, 0, 0); } while (0)
    PV_D0(0); PV_D0(1); PV_D0(2); PV_D0(3);
#undef PV_D0
#undef TRRD
}
struct BlockRef { const bf16_t* Q; const bf16_t* K; const bf16_t* V; bf16_t* O; const float* km; int nb; };
struct Seam { bf16x8 qr[8]; bf16x8 st_v0, st_v1, st_k0, st_k1; };
#define ROW(p, k0, rr) ((p) + (size_t)((k0) + (rr)) * LDP + sc)
#define VMWN(n) asm volatile("s_waitcnt vmcnt(%0)" :: "i"(n) : "memory")
#define SLOAD_H(Kp, Vp, k0) do { S.st_v0 = load8(ROW(Vp, k0, sr)); S.st_v1 = load8(ROW(Vp, k0, 32 + sr));              \
                         S.st_k0 = load8(ROW(Kp, k0, sr)); S.st_k1 = load8(ROW(Kp, k0, 32 + sr)); } while (0)
#define SWRITE_HK(bf) do { *(bf16x8*)(K_lds + (bf) * SHM_K + kws) = S.st_k0; *(bf16x8*)(K_lds + (bf) * SHM_K + kws + 32 * 256) = S.st_k1; } while (0)
#define SWRITE_HV(bf) do { *(bf16x8*)(V_lds + (bf) * SHM_V + vst0) = S.st_v0; *(bf16x8*)(V_lds + (bf) * SHM_V + vst1) = S.st_v1; } while (0)
#define SWRITE_H(bf) do { SWRITE_HV(bf); SWRITE_HK(bf); } while (0)
__device__ __forceinline__ void moba_prime(const BlockRef& cur, char* lds, Seam& S) {
    const int tid = threadIdx.x, wid = __builtin_amdgcn_readfirstlane(tid >> 6), lane = tid & 63, r32 = lane & 31, hi = lane >> 5;
    const int sr = tid >> 4, sc = (tid & 15) * 8, kws = KSWZ(sr, sc * 2); char* K_lds = lds + 2 * SHM_V;
    for (int d0 = 0; d0 < 8; ++d0) S.qr[d0] = load8(cur.Q + (size_t)(wid * QBLK + r32) * LDP + d0 * 16 + hi * 8);
    SLOAD_H(cur.K, cur.V, 0); VM_WAIT(); SWRITE_HK(0);
    __syncthreads();
}
__device__ __forceinline__ void moba_block(const BlockRef& cur, const BlockRef& nxt, char* lds, Seam& S) {
    const int tid = threadIdx.x, wid = __builtin_amdgcn_readfirstlane(tid >> 6), lane = tid & 63, r32 = lane & 31, hi = lane >> 5;
    const int P0 = cur.nb * QB;
    const int NT = (P0 + QB) / KVBLK;
    const int qlo = P0 + wid * QBLK, qm = qlo + r32 - 4 * hi;
    char* V_lds = lds; char* K_lds = lds + 2 * SHM_V;
    float* ws = (float*)(lds + 2 * SHM_V + 2 * SHM_K) + wid * 64; float* li_l = ws, * al_l = ws + 32;
    float m_reg = -1e30f, l_reg = 0; f32x16 o[4] = {};
    const int sr = tid >> 4, sc = (tid & 15) * 8, vst0 = v_st(sr, sc), vst1 = v_st(32 + sr, sc), kws = KSWZ(sr, sc * 2);
    const int vb0 = (int)(uintptr_t)V_lds + v_rd_base(lane);
    const bf16_t* Kh = cur.K; const bf16_t* Vh = cur.V;
    unsigned selbits = 0xffu; const bool needsel = cur.nb >= 4;
    if (needsel) {
        float g[7];
#pragma unroll
        for (int j = 0; j < 7; ++j) {
            float s = 0.f;
            if (j < cur.nb) {
#pragma unroll
                for (int d0 = 0; d0 < 8; ++d0) {
                    const f32x4 k0 = *(const f32x4*)(cur.km + j * 128 + d0 * 16 + hi * 8), k1 = *(const f32x4*)(cur.km + j * 128 + d0 * 16 + hi * 8 + 4);
                    const u32x4 qw = *reinterpret_cast<const u32x4*>(&S.qr[d0]);
                    s += bf_lo(qw.x) * k0[0] + bf_hi(qw.x) * k0[1] + bf_lo(qw.y) * k0[2] + bf_hi(qw.y) * k0[3]
                       + bf_lo(qw.z) * k1[0] + bf_hi(qw.z) * k1[1] + bf_lo(qw.w) * k1[2] + bf_hi(qw.w) * k1[3];
                }
                auto rr = __builtin_amdgcn_permlane32_swap(__float_as_uint(s), __float_as_uint(s), false, false);
                s = __uint_as_float(rr[0]) + __uint_as_float(rr[1]);
            } else s = -3.0e38f;
            g[j] = s;
        }
        selbits = 0u;
#pragma unroll
        for (int j = 0; j < 7; ++j) { int rank = 0;
#pragma unroll
            for (int k = 0; k < 7; ++k) if (k != j) rank += (g[k] > g[j] || (g[k] == g[j] && k < j)) ? 1 : 0;
            if (rank < 3 && j < cur.nb) selbits |= 1u << j; }
    }
#define RESC(a) do { if (__any((a) < 1.f)) { if (hi == 0) al_l[r32] = (a); asm volatile("s_waitcnt lgkmcnt(0)" ::: "memory");              \
                     for (int d_ = 0; d_ < 4; ++d_) for (int r = 0; r < 16; ++r) o[d_][r] *= al_l[crow(r, hi)]; } } while (0)
#define KBASE(t) ((t) * KVBLK)
#define MASKT(P0_, P1_, t) do { const int kb_ = KBASE(t); \
        if (kb_ >= P0) { if (kb_ + KVBLK - 1 > qlo) mask_tile(P0_, P1_, qm - kb_); } \
        else if (needsel) { mask_all(P0_, P1_, ((selbits >> (kb_ >> 8)) & 1u) == 0u); } } while (0)
    constexpr int NQL = 8;
#define SEAM_K0() do { VMWN(NQL); SWRITE_HK(0); SBAR(); } while (0)
    f32x16 pA0, pA1, pB0, pB1; float mnA, mnB, alA, alB; bf16x8 pa0, pa1, pa2, pa3;
    SWRITE_HV(0); SBAR();
    if (NT > 1) { SLOAD_H(Kh, Vh, KBASE(1)); }
    SBAR(); qkt<0>(pA0, pA1, K_lds, r32, hi, S.qr);
    MASKT(pA0, pA1, 0); partialSM(pA0, pA1, m_reg, mnA, alA);
    if (NT > 1) { VM_WAIT(); SWRITE_H(1); }
    __syncthreads();
#define HALF_STEP(PX0, PX1, mnX, alX, PY0, PY1, alY, t, KB, VB, SB) do {                                                      \
        SBAR(); qkt<KB>(PX0, PX1, K_lds, r32, hi, S.qr);                                                                      \
        finishSM(PY0, PY1, alY, l_reg, pa0, pa1, pa2, pa3); SBAR();                                                           \
        if ((t) + 1 < NT) { SLOAD_H(Kh, Vh, KBASE((t) + 1)); SBAR(); }                                                        \
        pv_tile<VB>(o, vb0, pa0, pa1, pa2, pa3); MASKT(PX0, PX1, (t)); partialSM(PX0, PX1, m_reg, mnX, alX);                  \
        __syncthreads();                                                                                                      \
        if ((t) + 1 < NT) { VM_WAIT(); SWRITE_H(SB); }                                                                        \
        RESC(alX); __syncthreads(); } while (0)
    for (int t = 1; t + 1 < NT; t += 2) {
        HALF_STEP(pB0, pB1, mnB, alB, pA0, pA1, alA, t, 1, 0, 0);
        HALF_STEP(pA0, pA1, mnA, alA, pB0, pB1, alB, t + 1, 0, 1, 1);
    }
    SBAR(); qkt<1>(pB0, pB1, K_lds, r32, hi, S.qr); SBAR();
    SLOAD_H(nxt.K, nxt.V, 0); SBAR();
#pragma unroll
    for (int d0 = 0; d0 < 8; ++d0) S.qr[d0] = load8(nxt.Q + (size_t)(wid * QBLK + r32) * LDP + d0 * 16 + hi * 8);
    SBAR();
    finishSM(pA0, pA1, alA, l_reg, pa0, pa1, pa2, pa3); SBAR();
    pv_tile<0>(o, vb0, pa0, pa1, pa2, pa3);
    MASKT(pB0, pB1, NT - 1); partialSM(pB0, pB1, m_reg, mnB, alB); __syncthreads(); RESC(alB);
    finishSM(pB0, pB1, alB, l_reg, pa0, pa1, pa2, pa3); SBAR(); pv_tile<1>(o, vb0, pa0, pa1, pa2, pa3);
    SBAR(); SEAM_K0();
    if (hi == 0) li_l[r32] = l_reg; asm volatile("s_waitcnt lgkmcnt(0)" ::: "memory");
    float rli[16];
#pragma unroll
    for (int r = 0; r < 16; ++r) rli[r] = __builtin_amdgcn_rcpf(li_l[crow(r, hi)]);
    char* pl = (char*)(cur.O + (size_t)(wid * QBLK + 4 * hi) * LDP + r32);
    asm volatile("" : "+v"(pl));
#pragma unroll
    for (int r = 0; r < 16; ++r) { const int orow0 = (r & 3) + 8 * (r >> 2);
#pragma unroll
        for (int d0 = 0; d0 < 4; ++d0) { const float v = o[d0][r] * rli[r];
            const float vn = __shfl_xor(v, 1);
            if ((r32 & 1) == 0) *(unsigned*)(pl + (size_t)orow0 * LDP * 2 + d0 * 64) = cvtpk(v, vn); } }
    __syncthreads();
#undef RESC
#undef KBASE
#undef MASKT
#undef SEAM_K0
#undef HALF_STEP
}
#undef ROW
#undef VMWN
#undef SLOAD_H
#undef SWRITE_HK
#undef SWRITE_HV
#undef SWRITE_H
}

struct EpiIn {
    static constexpr int PID = 1;
    static constexpr bool PERM = true;
    bf16_t* Z; const float* r0; const float* cosT; const float* sinT;
    __device__ __forceinline__ void operator()(f32x4 (&acc)[2][2][4][2], const pg8::Unit& u, int wr, int wc, int fr, int fq) const {
        const int type = u.pn >> 2;
        bf16_t* base = Z + (size_t)type * (ZSTRIDE / 2);
        const int colt = (u.pn & 3) * 256 + wc * 32 + 8 * fq;
        const int row0 = u.pm * 256 + wr * 64 + fr;
        const bool rot = (type == 2 || type == 3) && wc == 0;
#pragma unroll
        for (int ai = 0; ai < 2; ++ai)
#pragma unroll
            for (int m = 0; m < 4; ++m) {
                const int row = row0 + ai * 128 + m * 16; const float rs = r0[row];
                f32x4 v[2][2];
#pragma unroll
                for (int bj = 0; bj < 2; ++bj)
#pragma unroll
                    for (int n = 0; n < 2; ++n) v[bj][n] = acc[ai][bj][m][n] * rs;
                if (type == 1) {
#pragma unroll
                    for (int bj = 0; bj < 2; ++bj)
#pragma unroll
                        for (int n = 0; n < 2; ++n)
#pragma unroll
                            for (int j = 0; j < 4; ++j) { const float x = v[bj][n][j]; v[bj][n][j] = x * fast_sigmoid(1.5957691216057308f * (x + 0.044715f * x * x * x)); }
                } else if (type >= 5) {
#pragma unroll
                    for (int bj = 0; bj < 2; ++bj)
#pragma unroll
                        for (int n = 0; n < 2; ++n)
#pragma unroll
                            for (int j = 0; j < 4; ++j) v[bj][n][j] = fast_sigmoid(v[bj][n][j]);
                } else if (rot) {
                    const int pos = row & (SEQ - 1);
#pragma unroll
                    for (int n = 0; n < 2; ++n) {
                        const int i0 = (8 * fq + 4 * n) & 15;
                        const f32x4 c = *(const f32x4*)(cosT + pos * 16 + i0), s = *(const f32x4*)(sinT + pos * 16 + i0);
#pragma unroll
                        for (int bj = 0; bj < 2; ++bj)
#pragma unroll
                            for (int j = 0; j < 4; ++j) { const float mine = v[bj][n][j], other = __shfl_xor(mine, 32);
                                v[bj][n][j] = (fq < 2) ? (mine * c[j] - other * s[j]) : (mine * c[j] + other * s[j]); }
                    }
                }
                bf16_t* rowp = base + (size_t)row * 1024 + colt;
#pragma unroll
                for (int bj = 0; bj < 2; ++bj) { u32x4 w; w.x = cvt_pk_bf16(v[bj][0][0], v[bj][0][1]); w.y = cvt_pk_bf16(v[bj][0][2], v[bj][0][3]); w.z = cvt_pk_bf16(v[bj][1][0], v[bj][1][1]); w.w = cvt_pk_bf16(v[bj][1][2], v[bj][1][3]);
                    *(u32x4*)(rowp + bj * 128) = w; }
            }
    }
};
struct EpiProjRnn {
    static constexpr int PID = 3;
    static constexpr bool PERM = false;
    float* T; const bf16_t* S1;
    __device__ __forceinline__ void operator()(f32x4 (&acc)[2][2][4][2], const pg8::Unit& u, int wr, int wc, int fr, int fq) const {
        const int row0 = u.pm * 256 + wr * 64 + fr, col0 = u.pn * 256 + wc * 32 + 4 * fq;
#pragma unroll
        for (int ai = 0; ai < 2; ++ai)
#pragma unroll
            for (int m = 0; m < 4; ++m) { const size_t off = (size_t)(row0 + ai * 128 + m * 16) * 1024 + col0;
#pragma unroll
                for (int bj = 0; bj < 2; ++bj)
#pragma unroll
                    for (int n = 0; n < 2; ++n) { const u32x2 sw = *(const u32x2*)(S1 + off + bj * 128 + n * 16);
                        f32x4 a = acc[ai][bj][m][n]; a[0] *= bf_lo(sw.x); a[1] *= bf_hi(sw.x); a[2] *= bf_lo(sw.y); a[3] *= bf_hi(sw.y);
                        *(f32x4*)(T + off + bj * 128 + n * 16) = a; } }
    }
};
struct EpiProjAttn {
    static constexpr int PID = 3;
    static constexpr bool PERM = false;
    const float* T; const bf16_t* S2; bf16_t* MIX;
    __device__ __forceinline__ void operator()(f32x4 (&acc)[2][2][4][2], const pg8::Unit& u, int wr, int wc, int fr, int fq) const {
        const int row0 = u.pm * 256 + wr * 64 + fr, col0 = u.pn * 256 + wc * 32 + 4 * fq;
#pragma unroll
        for (int ai = 0; ai < 2; ++ai)
#pragma unroll
            for (int m = 0; m < 4; ++m) { const size_t off = (size_t)(row0 + ai * 128 + m * 16) * 1024 + col0;
#pragma unroll
                for (int bj = 0; bj < 2; ++bj)
#pragma unroll
                    for (int n = 0; n < 2; ++n) { const u32x2 sw = *(const u32x2*)(S2 + off + bj * 128 + n * 16); const f32x4 t = *(const f32x4*)(T + off + bj * 128 + n * 16);
                        const f32x4 a = acc[ai][bj][m][n];
                        u32x2 w; w.x = cvt_pk_bf16(t[0] + a[0] * bf_lo(sw.x), t[1] + a[1] * bf_hi(sw.x)); w.y = cvt_pk_bf16(t[2] + a[2] * bf_lo(sw.y), t[3] + a[3] * bf_hi(sw.y));
                        *(u32x2*)(MIX + off + bj * 128 + n * 16) = w; } }
    }
};
struct EpiOut {
    static constexpr int PID = 4;
    static constexpr bool PERM = false;
    const float* X; float* X1; bf16_t* X1B;
    __device__ __forceinline__ void operator()(f32x4 (&acc)[2][2][4][2], const pg8::Unit& u, int wr, int wc, int fr, int fq) const {
        const int row0 = u.pm * 256 + wr * 64 + fr, col0 = u.pn * 256 + wc * 32 + 4 * fq;
#pragma unroll
        for (int ai = 0; ai < 2; ++ai)
#pragma unroll
            for (int m = 0; m < 4; ++m) { const size_t off = (size_t)(row0 + ai * 128 + m * 16) * 1024 + col0;
#pragma unroll
                for (int bj = 0; bj < 2; ++bj)
#pragma unroll
                    for (int n = 0; n < 2; ++n) { const f32x4 xv = *(const f32x4*)(X + off + bj * 128 + n * 16); const f32x4 o = xv + acc[ai][bj][m][n];
                        *(f32x4*)(X1 + off + bj * 128 + n * 16) = o;
                        u32x2 w; w.x = cvt_pk_bf16(o[0], o[1]); w.y = cvt_pk_bf16(o[2], o[3]); *(u32x2*)(X1B + off + bj * 128 + n * 16) = w; } }
    }
};
struct EpiGu {
    static constexpr int PID = 6;
    static constexpr bool PERM = true;
    bf16_t* ACT; const float* bgu; const float* r1; const int* elist;
    __device__ __forceinline__ void operator()(f32x4 (&acc)[2][2][4][2], const pg8::Unit& u, int wr, int wc, int fr, int fq) const {
        const int c0 = u.pn * 128 + wc * 32 + 8 * fq;
        const float* bg = bgu + (size_t)u.e * 2048 + c0;
        f32x4 bgl[2], bln[2];
#pragma unroll
        for (int n = 0; n < 2; ++n) { bgl[n] = *(const f32x4*)(bg + 4 * n); bln[n] = *(const f32x4*)(bg + 1024 + 4 * n); }
#pragma unroll
        for (int ai = 0; ai < 2; ++ai)
#pragma unroll
            for (int m = 0; m < 4; ++m) {
                const int rt = ai * 128 + wr * 64 + m * 16 + fr; int r = u.rbase + rt; r = r < u.cnt ? r : u.cnt - 1;
                const int id = elist[(size_t)u.e * MTOK + r]; const float rs = r1[id >> 2];
                float a8[8];
#pragma unroll
                for (int n = 0; n < 2; ++n)
#pragma unroll
                    for (int j = 0; j < 4; ++j) { float g = acc[ai][0][m][n][j] * rs + bgl[n][j], l = acc[ai][1][m][n][j] * rs + bln[n][j];
                        g = fminf(g, 7.0f); l = fminf(fmaxf(l, -7.0f), 7.0f);
                        a8[4 * n + j] = g * fast_sigmoid(1.702f * g) * (l + 1.0f); }
                u32x4 w; w.x = cvt_pk_bf16(a8[0], a8[1]); w.y = cvt_pk_bf16(a8[2], a8[3]); w.z = cvt_pk_bf16(a8[4], a8[5]); w.w = cvt_pk_bf16(a8[6], a8[7]);
                *(u32x4*)(ACT + (size_t)(u.pm * 256 + rt) * 1024 + c0) = w;
            }
    }
};
struct EpiDown {
    static constexpr int PID = 7;
    static constexpr bool PERM = true;
    bf16_t* CON; const float* bd; const float* gw; const int* elist;
    __device__ __forceinline__ void operator()(f32x4 (&acc)[2][2][4][2], const pg8::Unit& u, int wr, int wc, int fr, int fq) const {
        const int c0 = u.pn * 256 + wc * 32 + 8 * fq;
        const float* bp = bd + (size_t)u.e * 1024 + c0;
        f32x4 bv[2][2];
#pragma unroll
        for (int bj = 0; bj < 2; ++bj)
#pragma unroll
            for (int n = 0; n < 2; ++n) bv[bj][n] = *(const f32x4*)(bp + bj * 128 + 4 * n);
#pragma unroll
        for (int ai = 0; ai < 2; ++ai)
#pragma unroll
            for (int m = 0; m < 4; ++m) {
                const int r = u.rbase + ai * 128 + wr * 64 + m * 16 + fr;
                if (r < u.cnt) {
                    const int id = elist[(size_t)u.e * MTOK + r]; const float w8 = gw[id];
                    bf16_t* rowp = CON + (size_t)id * 1024 + c0;
#pragma unroll
                    for (int bj = 0; bj < 2; ++bj) { const f32x4 v0 = (acc[ai][bj][m][0] + bv[bj][0]) * w8, v1 = (acc[ai][bj][m][1] + bv[bj][1]) * w8;
                        u32x4 w; w.x = cvt_pk_bf16(v0[0], v0[1]); w.y = cvt_pk_bf16(v0[2], v0[3]); w.z = cvt_pk_bf16(v1[0], v1[1]); w.w = cvt_pk_bf16(v1[2], v1[3]);
                        *(u32x4*)(rowp + bj * 128) = w; }
                }
            }
    }
};

struct Args { const float* in[21]; float* out; unsigned char* ws; int ph_lo, ph_hi; };
struct Ctx {
    int tid, lane, wave, vcu, G;
    LAS unsigned char* lds;
    unsigned char* ws;
};
constexpr int N_PHASES = 9;

template <bool GU>
__device__ __forceinline__ void transpose_item(const float* W, int K, int N, bf16_t* WT, const float* g, LAS float* scr, int item, int lane) {
    const int nblk = N / 64, kb = item / nblk, nb = item - kb * nblk, k0 = 64 * kb, n0 = 64 * nb;
    f32x4 v[16];
#pragma unroll
    for (int r = 0; r < 16; ++r) { const int k = 4 * r + (lane >> 4); v[r] = *(const f32x4*)(W + (size_t)(k0 + k) * N + n0 + 4 * (lane & 15)); }
#pragma unroll
    for (int r = 0; r < 16; ++r) { const int k = 4 * r + (lane >> 4); const float s = g ? g[k0 + k] : 1.0f; LAS float* p = scr + k * 65 + 4 * (lane & 15);
        p[0] = v[r][0] * s; p[1] = v[r][1] * s; p[2] = v[r][2] * s; p[3] = v[r][3] * s; }
    LDS_WAIT(); asm volatile("" ::: "memory");
    const int c = lane & 7;
#pragma unroll
    for (int j = 0; j < 8; ++j) { const int n = (lane >> 3) + 8 * j; const LAS float* s = scr + (8 * c) * 65 + n;
        u32x4 o; o.x = cvt_pk_bf16(s[0 * 65], s[1 * 65]); o.y = cvt_pk_bf16(s[2 * 65], s[3 * 65]); o.z = cvt_pk_bf16(s[4 * 65], s[5 * 65]); o.w = cvt_pk_bf16(s[6 * 65], s[7 * 65]);
        int nn = n0 + n;
        if (GU) { nn = (nn < 1024) ? ((nn >> 7) * 256 + (nn & 127)) : (((nn - 1024) >> 7) * 256 + 128 + (nn & 127)); }
        *(u32x4*)(WT + (size_t)nn * K + k0 + 8 * c) = o; }
    LDS_WAIT(); asm volatile("" ::: "memory");
}
__device__ __forceinline__ void p0_prologue(const Ctx& C, const Args& A) {
    LAS float* scr = (LAS float*)(C.lds + C.wave * 16640);
    const int gw = C.vcu * NWAVES + C.wave, NGW = C.G * NWAVES, lane = C.lane;
    unsigned char* ws = C.ws;
    { const float* x = A.in[0]; bf16_t* XB = (bf16_t*)(ws + WS_XB); float* r0 = (float*)(ws + WS_R0);
      for (int m = gw; m < MTOK; m += NGW) { const f32x4* xr = (const f32x4*)(x + (size_t)m * DM) + lane; f32x4 v[4]; float s = 0.f;
#pragma unroll
          for (int j = 0; j < 4; ++j) { v[j] = xr[64 * j]; s += (v[j][0] * v[j][0] + v[j][1] * v[j][1]) + (v[j][2] * v[j][2] + v[j][3] * v[j][3]); }
          s = wave_sum(s); if (lane == 0) r0[m] = 1.0f / sqrtf(s * (1.0f / DM) + EPS);
          u32x2* o8 = (u32x2*)(XB + (size_t)m * DM) + lane;
#pragma unroll
          for (int j = 0; j < 4; ++j) { u32x2 w; w.x = cvt_pk_bf16(v[j][0], v[j][1]); w.y = cvt_pk_bf16(v[j][2], v[j][3]); o8[64 * j] = w; } } }
    constexpr int I_IN = 16 * (NIN / 64), I_SQ = 16 * 16, I_GU = NEXP * 16 * 32, I_DN = NEXP * 16 * 16;
    constexpr int NITEMS = I_IN + 3 * I_SQ + I_GU + I_DN;
    for (int it = gw; it < NITEMS; it += NGW) {
        int r = it;
        if (r < I_GU) { const int e = r / (16 * 32); transpose_item<true>(A.in[16] + (size_t)e * 1024 * 2048, 1024, 2048, (bf16_t*)(ws + WS_WGU) + (size_t)e * 2048 * 1024, A.in[13], scr, r - e * 16 * 32, lane); continue; } r -= I_GU;
        if (r < I_DN) { const int e = r / (16 * 16); transpose_item<false>(A.in[18] + (size_t)e * 1024 * 1024, 1024, 1024, (bf16_t*)(ws + WS_WD) + (size_t)e * 1024 * 1024, nullptr, scr, r - e * 16 * 16, lane); continue; } r -= I_DN;
        if (r < I_IN) { transpose_item<false>(A.in[2], 1024, NIN, (bf16_t*)(ws + WS_WIN), A.in[1], scr, r, lane); continue; } r -= I_IN;
        if (r < I_SQ) { transpose_item<false>(A.in[10], 1024, 1024, (bf16_t*)(ws + WS_WR), nullptr, scr, r, lane); continue; } r -= I_SQ;
        if (r < I_SQ) { transpose_item<false>(A.in[11], 1024, 1024, (bf16_t*)(ws + WS_WA), nullptr, scr, r, lane); continue; } r -= I_SQ;
        transpose_item<false>(A.in[12], 1024, 1024, (bf16_t*)(ws + WS_WO), nullptr, scr, r, lane);
    }
    { float* cosT = (float*)(ws + WS_COS); float* sinT = (float*)(ws + WS_SIN); float* sp = (float*)(ws + WS_SP);
      const int gt = C.vcu * 512 + C.tid, NT = C.G * 512;
      for (int i = gt; i < SEQ * 16; i += NT) { const int pos = i >> 4, f = i & 15; const float inv = powf(500000.0f, -(float)f * 0.0625f); const float ang = (float)pos * inv; float s, c; sincosf(ang, &s, &c); cosT[i] = c; sinT[i] = s; }
      for (int i = gt; i < 1024; i += NT) { const float a = A.in[9][i]; sp[i] = log1pf(expf(-a)); } }
}

__device__ __forceinline__ void kmean_bh(const Ctx& C, int bh) {
    const bf16_t* Kt = (const bf16_t*)(C.ws + WS_Z + 3 * ZSTRIDE); float* km = (float*)(C.ws + WS_KMEAN) + (size_t)bh * 1024;
    const int b = bh >> 3, h = bh & 7, cc = C.tid & 15, rg = C.tid >> 4;
    LAS float* red = (LAS float*)C.lds;
    const bf16_t* kb = Kt + (size_t)(b * SEQ) * 1024 + h * 128 + cc * 8;
    for (int j = 0; j < 7; ++j) { float a[8] = {0.f, 0.f, 0.f, 0.f, 0.f, 0.f, 0.f, 0.f};
#pragma unroll
        for (int rr = 0; rr < 8; ++rr) { const u32x4 w = *(const u32x4*)(kb + (size_t)(256 * j + rg + 32 * rr) * 1024);
            a[0] += bf_lo(w.x); a[1] += bf_hi(w.x); a[2] += bf_lo(w.y); a[3] += bf_hi(w.y); a[4] += bf_lo(w.z); a[5] += bf_hi(w.z); a[6] += bf_lo(w.w); a[7] += bf_hi(w.w); }
        LAS float* p = red + (j * 32 + rg) * 128 + cc * 8;
#pragma unroll
        for (int q = 0; q < 8; ++q) p[q] = a[q]; }
    __syncthreads();
    for (int o = C.tid; o < 7 * 128; o += 512) { const int j = o >> 7, d = o & 127; float s = 0.f;
        for (int r = 0; r < 32; ++r) s += red[(j * 32 + r) * 128 + d];
        km[j * 128 + d] = s * (1.0f / 256.0f); }
    VM_WAIT(); __syncthreads();
}

__device__ __forceinline__ void rnn_item(const Ctx& C, const Args& A, int item) {
    constexpr int T = 128;
    const int b = item >> 4, g = item & 15, tid = C.tid, lane = C.lane, wid = C.wave;
    LAS unsigned char* L = C.lds;
    LAS bf16_t* XR = (LAS bf16_t*)(L);
    LAS bf16_t* GG = (LAS bf16_t*)(L + 16896);
    LAS bf16_t* XC = (LAS bf16_t*)(L + 33280);
    LAS float* AA = (LAS float*)(L + 49664);
    LAS float* UU = (LAS float*)(L + 82432);
    LAS float* SEGA = (LAS float*)(L + 115200);
    LAS float* SEGH = (LAS float*)(L + 117248);
    LAS float* CARRY = (LAS float*)(L + 119296);
    const bf16_t* ZX = (const bf16_t*)(C.ws + WS_Z); const bf16_t* ZG = (const bf16_t*)(C.ws + WS_Z + ZSTRIDE); bf16_t* HG = (bf16_t*)(C.ws + WS_HG);
    const size_t rowbase = (size_t)b * SEQ;
    const int ch0 = g * 64;
    const int c = tid & 63, sg = tid >> 6;
    float cw[4], cb;
#pragma unroll
    for (int k = 0; k < 4; ++k) cw[k] = A.in[3][k * 1024 + ch0 + c];
    cb = A.in[4][ch0 + c];
    const int r16 = lane & 15, q4 = lane >> 4;
    float bxv[4], bav[4], spv[4];
#pragma unroll
    for (int n = 0; n < 4; ++n) { bxv[n] = A.in[6][ch0 + 16 * n + r16]; bav[n] = A.in[8][ch0 + 16 * n + r16]; spv[n] = ((const float*)(C.ws + WS_SP))[ch0 + 16 * n + r16]; }
    bf16x8 Bx[2][4], Ba[2][4];
    { const float* wx = A.in[5] + (size_t)g * 4096; const float* wa = A.in[7] + (size_t)g * 4096;
#pragma unroll
      for (int kk = 0; kk < 2; ++kk)
#pragma unroll
          for (int n = 0; n < 4; ++n) { float fx[8], fa[8];
#pragma unroll
              for (int jj = 0; jj < 8; ++jj) { const int i = 32 * kk + 8 * q4 + jj; fx[jj] = wx[i * 64 + 16 * n + r16]; fa[jj] = wa[i * 64 + 16 * n + r16]; }
              u32x4 wxp = {cvt_pk_bf16(fx[0], fx[1]), cvt_pk_bf16(fx[2], fx[3]), cvt_pk_bf16(fx[4], fx[5]), cvt_pk_bf16(fx[6], fx[7])};
              u32x4 wap = {cvt_pk_bf16(fa[0], fa[1]), cvt_pk_bf16(fa[2], fa[3]), cvt_pk_bf16(fa[4], fa[5]), cvt_pk_bf16(fa[6], fa[7])};
              Bx[kk][n] = *reinterpret_cast<bf16x8*>(&wxp); Ba[kk][n] = *reinterpret_cast<bf16x8*>(&wap); } }
    if (tid < 128) CARRY[tid] = 0.f;
    u32x4 px[2], pg[2], ph = {0u, 0u, 0u, 0u};
#define RNN_LOAD(t0) do { _Pragma("unroll") for (int i = 0; i < 2; ++i) { const int p = tid + 512 * i, row = p >> 3, c8 = p & 7; \
        const size_t go = (rowbase + (t0) + row) * 1024 + ch0 + c8 * 8; px[i] = *(const u32x4*)(ZX + go); pg[i] = *(const u32x4*)(ZG + go); } \
        if (tid < 24) { const int row = tid >> 3, c8 = tid & 7; ph = ((t0) > 0) ? *(const u32x4*)(ZX + (rowbase + (t0) - 3 + row) * 1024 + ch0 + c8 * 8) : (u32x4){0u, 0u, 0u, 0u}; } } while (0)
    RNN_LOAD(0);
    __syncthreads();
    for (int ck = 0; ck < SEQ / T; ++ck) {
        const int t0 = ck * T;
#pragma unroll
        for (int i = 0; i < 2; ++i) { const int p = tid + 512 * i, row = p >> 3, c8 = p & 7; *(LAS u32x4*)(XR + (row + 3) * 64 + c8 * 8) = px[i]; *(LAS u32x4*)(GG + row * 64 + c8 * 8) = pg[i]; }
        if (tid < 24) { const int row = tid >> 3, c8 = tid & 7; *(LAS u32x4*)(XR + row * 64 + c8 * 8) = ph; }
        __syncthreads();
        if (ck + 1 < SEQ / T) RNN_LOAD(t0 + T);
        { float x0 = bf2f(XR[(sg * 16 + 0) * 64 + c]), x1 = bf2f(XR[(sg * 16 + 1) * 64 + c]), x2 = bf2f(XR[(sg * 16 + 2) * 64 + c]);
#pragma unroll
          for (int tt = 0; tt < 16; ++tt) { const int t = sg * 16 + tt; const float x3 = bf2f(XR[(t + 3) * 64 + c]);
              const float y = cb + cw[0] * x0 + cw[1] * x1 + cw[2] * x2 + cw[3] * x3;
              XC[t * 64 + c] = (bf16_t)(cvt_pk_bf16(y, 0.f) & 0xffffu); x0 = x1; x1 = x2; x2 = x3; } }
        __syncthreads();
        { bf16x8 Af[2];
#pragma unroll
          for (int kk = 0; kk < 2; ++kk) Af[kk] = *(const LAS bf16x8*)(XC + (16 * wid + r16) * 64 + 32 * kk + 8 * q4);
#pragma unroll
          for (int n = 0; n < 4; ++n) { f32x4 ax = {0.f, 0.f, 0.f, 0.f}, aa = {0.f, 0.f, 0.f, 0.f};
#pragma unroll
              for (int kk = 0; kk < 2; ++kk) { ax = __builtin_amdgcn_mfma_f32_16x16x32_bf16(Af[kk], Bx[kk][n], ax, 0, 0, 0); aa = __builtin_amdgcn_mfma_f32_16x16x32_bf16(Af[kk], Ba[kk][n], aa, 0, 0, 0); }
#pragma unroll
              for (int rg = 0; rg < 4; ++rg) { const int t = 16 * wid + 4 * q4 + rg, j = 16 * n + r16;
                  const float gx = fast_sigmoid(ax[rg] + bxv[n]), ga = fast_sigmoid(aa[rg] + bav[n]);
                  const float la = -8.0f * ga * spv[n]; const float a = __builtin_amdgcn_exp2f(la * 1.4426950408889634f);
                  const float mlt = __builtin_amdgcn_sqrtf(fmaxf(1.0f - a * a, 0.f));
                  const float xc = bf2f(XC[t * 64 + j]);
                  AA[t * 64 + j] = a; UU[t * 64 + j] = mlt * gx * xc; } } }
        __syncthreads();
        float av[16], uv[16];
        { float Ap = 1.f, Hp = 0.f;
#pragma unroll
          for (int tt = 0; tt < 16; ++tt) { const int t = sg * 16 + tt; av[tt] = AA[t * 64 + c]; uv[tt] = UU[t * 64 + c]; Hp = av[tt] * Hp + uv[tt]; Ap *= av[tt]; }
          SEGA[sg * 64 + c] = Ap; SEGH[sg * 64 + c] = Hp; }
        __syncthreads();
        { float h = CARRY[(ck & 1) * 64 + c];
          for (int s2 = 0; s2 < sg; ++s2) h = SEGA[s2 * 64 + c] * h + SEGH[s2 * 64 + c];
#pragma unroll
          for (int tt = 0; tt < 16; ++tt) { const int t = sg * 16 + tt; h = av[tt] * h + uv[tt]; const float o = h * bf2f(GG[t * 64 + c]); XC[t * 64 + c] = (bf16_t)(cvt_pk_bf16(o, 0.f) & 0xffffu); }
          if (sg == 7) CARRY[((ck + 1) & 1) * 64 + c] = h; }
        __syncthreads();
#pragma unroll
        for (int i = 0; i < 2; ++i) { const int p = tid + 512 * i, row = p >> 3, c8 = p & 7; *(u32x4*)(HG + (rowbase + t0 + row) * 1024 + ch0 + c8 * 8) = *(const LAS u32x4*)(XC + row * 64 + c8 * 8); }
    }
    __syncthreads();
#undef RNN_LOAD
}

__device__ __forceinline__ att::BlockRef att_ref(const Ctx& C, int L, int pass) {
    const int bh = L >> 2, x = L & 3, nb = pass ? 7 - x : x, b = bh >> 3, h = bh & 7;
    att::BlockRef r;
    const size_t seq0 = (size_t)(b * SEQ) * 1024 + h * 128;
    r.Q = (const bf16_t*)(C.ws + WS_Z + 2 * ZSTRIDE) + seq0 + (size_t)(nb * 256) * 1024;
    r.K = (const bf16_t*)(C.ws + WS_Z + 3 * ZSTRIDE) + seq0;
    r.V = (const bf16_t*)(C.ws + WS_Z + 4 * ZSTRIDE) + seq0;
    r.O = (bf16_t*)(C.ws + WS_OA) + seq0 + (size_t)(nb * 256) * 1024;
    r.km = (const float*)(C.ws + WS_KMEAN) + (size_t)bh * 1024; r.nb = nb;
    return r;
}
__device__ __forceinline__ void p2_mixers(const Ctx& C, const Args& A) {
    const int lo = (C.vcu * 512) / C.G, hi = ((C.vcu + 1) * 512) / C.G;
#ifndef NO_KM
    REP(22) { int prev = -1; for (int L = lo; L < hi; ++L) { const int bh = L >> 2; if (bh != prev) { kmean_bh(C, bh); prev = bh; } } }
#endif
#ifndef NO_RNN
    REP(20) for (int it = C.vcu; it < 256; it += C.G) rnn_item(C, A, it);
#endif
#ifndef NO_ATT
    REP(21) if (lo < hi) {
        int L = lo, pass = 0; att::Seam S;
        att::BlockRef cur = att_ref(C, L, 0);
        att::moba_prime(cur, (char*)C.lds, S);
        for (;;) {
            const bool more_pass = pass == 0, more_item = L + 1 < hi, last = !more_pass && !more_item;
            const int Ln = more_pass ? L : (more_item ? L + 1 : L), passn = more_pass ? 1 : 0;
            const att::BlockRef nxt = last ? cur : att_ref(C, Ln, passn);
            att::moba_block(cur, nxt, (char*)C.lds, S);
            if (last) break;
            cur = nxt; L = Ln; pass = passn;
        }
    }
#endif
}

__device__ __forceinline__ void p5_router(const Ctx& C, const Args& A, const float* X1) {
    LAS float* WRL = (LAS float*)C.lds;
    LAS int* hist = (LAS int*)(C.lds + MISC_OFF + 1024);
    LAS int* baseL = hist + 32;
    const int tid = C.tid, lane = C.lane, wid = C.wave;
    const float* rw = A.in[14]; const float* gff = A.in[13]; const float* rb = A.in[15];
    for (int i = tid; i < 1024 * 32 / 4; i += 512) { const f32x4 w = *(const f32x4*)(rw + 4 * i); const float s = gff[(4 * i) >> 5]; *(LAS f32x4*)(WRL + 4 * i) = w * s; }
    if (tid < 32) hist[tid] = 0;
    __syncthreads();
    unsigned* cntg = (unsigned*)(C.ws + WS_CTL) + CW_CNT;
    int* elist = (int*)(C.ws + WS_ELIST); float* gwp = (float*)(C.ws + WS_GW); float* r1p = (float*)(C.ws + WS_R1);
    const int j = lane & 31, h = lane >> 5;
    for (int bi = C.vcu; bi < MTOK / 128; bi += C.G) {
        int eidx[4] = {0, 0, 0, 0}; float gate[4] = {0.f, 0.f, 0.f, 0.f}; int rank[4] = {0, 0, 0, 0};
        const int tok = bi * 128 + wid * 32 + j;
        if (wid < 4) {
            const float* xr = X1 + (size_t)tok * 1024 + 4 * h;
            f32x16 acc = {}; float ss = 0.f;
            f32x4 va[16], vb[16];
#define RT_LOAD(dst, kc0) do { _Pragma("unroll") for (int q = 0; q < 16; ++q) dst[q] = *(const f32x4*)(xr + 8 * ((kc0) + q)); } while (0)
#define RT_COMP(src, kc0) do { _Pragma("unroll") for (int q = 0; q < 16; ++q) { const f32x4 v = src[q]; ss += (v[0] * v[0] + v[1] * v[1]) + (v[2] * v[2] + v[3] * v[3]); \
            const LAS float* wp = WRL + (8 * ((kc0) + q) + 4 * h) * 32 + j; \
            _Pragma("unroll") for (int e = 0; e < 4; ++e) acc = __builtin_amdgcn_mfma_f32_32x32x2f32(wp[e * 32], v[e], acc, 0, 0, 0); } } while (0)
            RT_LOAD(va, 0);
#pragma unroll 1
            for (int kc = 0; kc < 128; kc += 32) {
                RT_LOAD(vb, kc + 16);
                RT_COMP(va, kc);
                if (kc + 32 < 128) RT_LOAD(va, kc + 32);
                RT_COMP(vb, kc + 16);
            }
#undef RT_LOAD
#undef RT_COMP
            ss += __shfl_xor(ss, 32);
            const float r1 = 1.0f / sqrtf(ss * (1.0f / 1024.0f) + EPS);
            if (h == 0) r1p[tok] = r1;
            float lv[16];
#pragma unroll
            for (int r = 0; r < 16; ++r) lv[r] = acc[r] * r1 + rb[(r & 3) + 8 * (r >> 2) + 4 * h];
            float tv[4]; int ti[4];
#pragma unroll
            for (int k = 0; k < 4; ++k) { float best = -3.0e38f; int bi_ = 0;
#pragma unroll
                for (int r = 0; r < 16; ++r) { const bool better = lv[r] > best; best = better ? lv[r] : best; bi_ = better ? r : bi_; }
                tv[k] = best; ti[k] = (bi_ & 3) + 8 * (bi_ >> 2) + 4 * h;
#pragma unroll
                for (int r = 0; r < 16; ++r) lv[r] = (r == bi_) ? -3.0e38f : lv[r]; }
            float cv[8]; int ci[8];
#pragma unroll
            for (int k = 0; k < 4; ++k) { cv[k] = tv[k]; ci[k] = ti[k]; cv[4 + k] = __shfl_xor(tv[k], 32); ci[4 + k] = __shfl_xor(ti[k], 32); }
#pragma unroll
            for (int k = 0; k < 4; ++k) { float best = -3.0e38f; int bidx = 1 << 30, bq = 0;
#pragma unroll
                for (int q = 0; q < 8; ++q) { const bool better = (cv[q] > best) || (cv[q] == best && ci[q] < bidx); best = better ? cv[q] : best; bidx = better ? ci[q] : bidx; bq = better ? q : bq; }
                gate[k] = best; eidx[k] = bidx;
#pragma unroll
                for (int q = 0; q < 8; ++q) cv[q] = (q == bq) ? -3.0e38f : cv[q]; }
            { const float m = gate[0]; float den = 0.f;
#pragma unroll
              for (int k = 0; k < 4; ++k) { gate[k] = __expf(gate[k] - m); den += gate[k]; }
              const float inv = 1.0f / den;
#pragma unroll
              for (int k = 0; k < 4; ++k) gate[k] *= inv; }
            if (h == 0) {
#pragma unroll
                for (int k = 0; k < 4; ++k) rank[k] = __hip_atomic_fetch_add(&hist[eidx[k]], 1, __ATOMIC_RELAXED, __HIP_MEMORY_SCOPE_WORKGROUP);
            }
        }
        __syncthreads();
        if (tid < 32) { const int n = hist[tid]; baseL[tid] = n ? (int)__hip_atomic_fetch_add(cntg + 64 * tid, (unsigned)n, RLX_AGENT) : 0; }
        __syncthreads();
        if (wid < 4 && h == 0) {
#pragma unroll
            for (int k = 0; k < 4; ++k) { const int e = eidx[k], pos = baseL[e] + rank[k]; elist[(size_t)e * MTOK + pos] = tok * 4 + k; gwp[tok * 4 + k] = gate[k]; }
        }
        __syncthreads();
        if (tid < 32) hist[tid] = 0;
        __syncthreads();
    }
}

__device__ __forceinline__ void moe_tables(const Ctx& C, LAS int* tstart, LAS int* ecnt) {
    const unsigned* cntg = (const unsigned*)(C.ws + WS_CTL) + CW_CNT;
    if (C.tid < 64) { const int e = C.tid & 31; const int c = (int)__hip_atomic_load(cntg + 64 * e, RLX_AGENT); const int nt = (c + 255) >> 8;
        int incl = nt;
#pragma unroll
        for (int o = 1; o < 32; o <<= 1) { const int v = __shfl_up(incl, o, 32); if (e >= o) incl += v; }
        if (C.tid < 32) { ecnt[e] = c; tstart[e + 1] = incl; if (e == 0) tstart[0] = 0; } }
    __syncthreads();
}

__device__ __forceinline__ void p8_final(const Ctx& C, const Args& A, float* OUT) {
    const int gw = C.vcu * NWAVES + C.wave, NGW = C.G * NWAVES, lane = C.lane;
    const bf16_t* CON = (const bf16_t*)(C.ws + WS_CONTRIB); const float* gf = A.in[20];
    f32x4 gv[4];
#pragma unroll
    for (int j = 0; j < 4; ++j) gv[j] = *((const f32x4*)gf + lane + 64 * j);
    for (int m = gw; m < MTOK; m += NGW) {
        f32x4* xr = (f32x4*)(OUT + (size_t)m * DM) + lane; f32x4 v[4]; float s = 0.f;
#pragma unroll
        for (int j = 0; j < 4; ++j) v[j] = xr[64 * j];
#pragma unroll
        for (int k = 0; k < 4; ++k) { const u32x2* cr = (const u32x2*)(CON + (size_t)(m * 4 + k) * DM) + lane;
#pragma unroll
            for (int j = 0; j < 4; ++j) { const u32x2 w = cr[64 * j]; v[j][0] += bf_lo(w.x); v[j][1] += bf_hi(w.x); v[j][2] += bf_lo(w.y); v[j][3] += bf_hi(w.y); } }
#pragma unroll
        for (int j = 0; j < 4; ++j) s += (v[j][0] * v[j][0] + v[j][1] * v[j][1]) + (v[j][2] * v[j][2] + v[j][3] * v[j][3]);
        s = wave_sum(s); const float r = 1.0f / sqrtf(s * (1.0f / DM) + EPS);
#pragma unroll
        for (int j = 0; j < 4; ++j) xr[64 * j] = v[j] * r * gv[j];
    }
}

__global__ void __launch_bounds__(NWAVES * 64, 2) mega_fwd(Args args) {
    extern __shared__ __attribute__((aligned(16))) unsigned char lds_raw[];
    Ctx C;
    C.lds = (LAS unsigned char*)lds_raw; C.ws = args.ws;
    C.tid = threadIdx.x; C.lane = C.tid & 63; C.wave = __builtin_amdgcn_readfirstlane(C.tid >> 6);
    C.G = gridDim.x; { const int bx = blockIdx.x; C.vcu = (C.G % 8 == 0) ? (bx % 8) * (C.G / 8) + bx / 8 : bx; }
    volatile LAS unsigned* MISC = (volatile LAS unsigned*)(C.lds + MISC_OFF);
    for (int u = C.tid; u < (LDS_BYTES - MISC_OFF) / 4; u += NWAVES * 64) ((LAS unsigned*)(C.lds + MISC_OFF))[u] = 0u;
    __syncthreads();
    unsigned* ctl = (unsigned*)(args.ws + WS_CTL);
    const int lo = args.ph_lo, hi = args.ph_hi;
    const bool use_bar = (hi - lo) > 1;
    XcdBarrier bar; bar.bar = ctl + CW_BAR; bar.x = 0; bar.st = nullptr;
    if (use_bar) bar = xcd_barrier_post(ctl + CW_BAR, MISC + 8);
#ifndef PH_MASK
#define PH_MASK 0x1ff
#endif
#define IN(k) (((PH_MASK >> (k)) & 1) && lo <= (k) && (k) < hi)
#define SEAM(k) do { if (IN(k) && IN((k) + 1)) xcd_barrier(bar); } while (0)
    unsigned char* ws = args.ws;
    LAS int* tstart = (LAS int*)(C.lds + MISC_OFF + 2048);
    LAS int* ecnt = tstart + 64;

    if (IN(0)) { p0_prologue(C, args); SEAM(0); }

    if (IN(1)) {
        pg8::DenseOrder S{(const char*)(ws + WS_XB), (const char*)(ws + WS_WIN), MTOK / 256, NIN / 256, 1024, C.G, C.vcu, (PROBE_DUP == 1) ? 1 : ((PROBE_DUP2 == 1) ? 2 : 0)};
        EpiIn E{(bf16_t*)(ws + WS_Z), (const float*)(ws + WS_R0), (const float*)(ws + WS_COS), (const float*)(ws + WS_SIN)};
#if PROBE_STAGGER > 0
        if (C.vcu & 1) { const unsigned long long t0 = __builtin_amdgcn_s_memrealtime(); while (__builtin_amdgcn_s_memrealtime() - t0 < (unsigned long long)PROBE_STAGGER * 100ull) __builtin_amdgcn_s_sleep(8); }
#endif
        pg8::gemm_phase<EpiIn, pg8::DenseOrder, false>(C.lds, 1024, S, E);
        SEAM(1);
    }
    if (IN(2)) { p2_mixers(C, args); SEAM(2); }

    if (IN(3)) {
        { pg8::DenseOrder S{(const char*)(ws + WS_HG), (const char*)(ws + WS_WR), MTOK / 256, 4, 1024, C.G, C.vcu, 0};
          EpiProjRnn E{(float*)(ws + WS_TMP), (const bf16_t*)(ws + WS_Z + 5 * ZSTRIDE)};
          pg8::gemm_phase<EpiProjRnn, pg8::DenseOrder, false>(C.lds, 1024, S, E); }
        { pg8::DenseOrder S{(const char*)(ws + WS_OA), (const char*)(ws + WS_WA), MTOK / 256, 4, 1024, C.G, C.vcu, 0};
          EpiProjAttn E{(const float*)(ws + WS_TMP), (const bf16_t*)(ws + WS_Z + 6 * ZSTRIDE), (bf16_t*)(ws + WS_MIX)};
          pg8::gemm_phase<EpiProjAttn, pg8::DenseOrder, false>(C.lds, 1024, S, E); }
    }
    SEAM(3);
    if (IN(4)) {
        pg8::DenseOrder S{(const char*)(ws + WS_MIX), (const char*)(ws + WS_WO), MTOK / 256, 4, 1024, C.G, C.vcu, (PROBE_DUP == 4) ? 1 : ((PROBE_DUP2 == 4) ? 2 : 0)};
        EpiOut E{args.in[0], args.out, (bf16_t*)(ws + WS_X1B)};
        pg8::gemm_phase<EpiOut, pg8::DenseOrder, false>(C.lds, 1024, S, E);
        SEAM(4);
    }
    if (IN(5)) { p5_router(C, args, args.out); SEAM(5); }

    if (IN(6)) {
        moe_tables(C, tstart, ecnt);
        pg8::MoeOrder S{tstart, ecnt, (const char*)(ws + WS_X1B), (const char*)(ws + WS_WGU), (size_t)2048 * 1024 * 2, (const int*)(ws + WS_ELIST), 8, 1024, C.G, C.vcu, true};
        EpiGu E{(bf16_t*)(ws + WS_ACT), args.in[17], (const float*)(ws + WS_R1), (const int*)(ws + WS_ELIST)};
        pg8::gemm_phase<EpiGu, pg8::MoeOrder, true>(C.lds, 1024, S, E);
        SEAM(6);
    }
    if (IN(7)) {
        moe_tables(C, tstart, ecnt);
        pg8::MoeOrder S{tstart, ecnt, (const char*)(ws + WS_ACT), (const char*)(ws + WS_WD), (size_t)1024 * 1024 * 2, (const int*)(ws + WS_ELIST), 4, 1024, C.G, C.vcu, false};
        EpiDown E{(bf16_t*)(ws + WS_CONTRIB), args.in[19], (const float*)(ws + WS_GW), (const int*)(ws + WS_ELIST)};
        pg8::gemm_phase<EpiDown, pg8::MoeOrder, false>(C.lds, 1024, S, E);
        SEAM(7);
    }
    if (IN(8)) { p8_final(C, args, args.out); }
#undef IN
#undef SEAM
}

extern "C" void kernel_launch(void* const* d_in, const int* in_sizes, int n_in, void* d_out, int out_size, void* d_ws, size_t ws_size, hipStream_t stream) {
    static int grid = 0;
    if (grid == 0) {
        if (n_in != 21 || out_size != MTOK * DM || ws_size < WS_END) { fprintf(stderr, "kernel_launch: unexpected shapes (n_in %d out %d ws %zu)\n", n_in, out_size, ws_size); grid = -1; return; }
        int dev = 0, cus = 0, per_cu = 0;
        if (hipGetDevice(&dev) != hipSuccess || hipDeviceGetAttribute(&cus, hipDeviceAttributeMultiprocessorCount, dev) != hipSuccess) { grid = -1; return; }
        if (hipFuncSetAttribute((const void*)mega_fwd, hipFuncAttributeMaxDynamicSharedMemorySize, LDS_BYTES) != hipSuccess) { fprintf(stderr, "kernel_launch: hipFuncSetAttribute failed\n"); grid = -1; return; }
        if (hipOccupancyMaxActiveBlocksPerMultiprocessor(&per_cu, (const void*)mega_fwd, NWAVES * 64, LDS_BYTES) != hipSuccess || per_cu < 1) { fprintf(stderr, "kernel_launch: occupancy query says %d\n", per_cu); }
        (void)hipGetLastError();
        grid = cus;
    }
    if (grid < 0) return;
    (void)hipMemsetAsync((char*)d_ws + WS_CTL, 0, CTL_ZERO_BYTES, stream);
    Args a{};
    for (int i = 0; i < 21; ++i) a.in[i] = (const float*)d_in[i];
    a.out = (float*)d_out; a.ws = (unsigned char*)d_ws;
#if MK_N_LAUNCHES == 1
    a.ph_lo = 0; a.ph_hi = N_PHASES;
    hipLaunchKernelGGL(mega_fwd, dim3(grid), dim3(NWAVES * 64), LDS_BYTES, stream, a);
#else
    for (int p = 0; p < N_PHASES; ++p) for (int rep = 0; rep < ((PROBE_REP == p) ? 2 : 1); ++rep) { a.ph_lo = p; a.ph_hi = p + 1; hipLaunchKernelGGL(mega_fwd, dim3(grid), dim3(NWAVES * 64), LDS_BYTES, stream, a); }
#endif
}
```
